# Optimizing an MI355X kernel written in HIP

```python
import jax, jax.numpy as jnp
from jax import lax
import numpy as np

D_MODEL = 1024
BATCH = 4
SEQ = 4096
DEPTH = 4

N_EVEN = (DEPTH + 1) // 2
N_ODD = DEPTH // 2

A_HEADS = 4
A_DK = 128
A_DV = 128
A_WIDTH = A_HEADS * A_DK
B_HEADS = 4
B_DIM = 128
B_WIDTH = B_HEADS * B_DIM
AB_IN = 4 * A_WIDTH + 3 * B_WIDTH
AB_MIX = A_WIDTH + B_WIDTH
HGRN_CHUNK = 64
SB_BLOCK = 128

C_FFN = 6 * D_MODEL
C_HALF = C_FFN // 2
C_GROUPS = 8
C_GROUP_DIM = C_HALF // C_GROUPS
C_CHUNK = 128

MLP_HIDDEN = 4 * D_MODEL
EPS = 1e-6

kernel_name = "hybrid_hgrn2_stickbreak_gmlp_trunk"


def rms_norm(x, g):
    xf = x.astype(jnp.float32)
    y = xf * lax.rsqrt(jnp.mean(xf * xf, axis=-1, keepdims=True) + EPS)
    return (y * g.astype(jnp.float32)).astype(x.dtype)


def layer_norm(x, g, b):
    xf = x.astype(jnp.float32)
    mu = jnp.mean(xf, axis=-1, keepdims=True)
    xc = xf - mu
    y = xc * lax.rsqrt(jnp.mean(xc * xc, axis=-1, keepdims=True) + EPS)
    return (y * g.astype(jnp.float32) + b.astype(jnp.float32)).astype(x.dtype)


def hgrn2_mix(q, f_logit, i, g, lb, g_norm):
    dt = q.dtype
    bsz, s_len, _ = q.shape
    n_chunks = s_len // HGRN_CHUNK
    f32 = jnp.float32
    lb = lb.astype(f32)
    f = lb + (1.0 - lb) * jax.nn.sigmoid(f_logit.astype(f32))
    log_f = jnp.log(f)
    k = 1.0 - f
    qf = jax.nn.silu(q.astype(f32))
    v = i.astype(f32)

    def to_chunks(t):
        return t.reshape(bsz, n_chunks, HGRN_CHUNK, A_HEADS, -1).transpose(1, 0, 3, 2, 4)

    qc, kc, vc, lfc = to_chunks(qf), to_chunks(k), to_chunks(v), to_chunks(log_f)
    tri = jnp.tril(jnp.ones((HGRN_CHUNK, HGRN_CHUNK), dtype=bool))

    def step(state, xs):
        qj, kj, vj, lfj = xs
        b = jnp.cumsum(lfj, axis=2)
        diff = b[:, :, :, None, :] - b[:, :, None, :, :]
        decay = jnp.exp(jnp.where(tri[:, :, None], diff, -jnp.inf))
        scores = jnp.einsum('bhtd,bhtsd,bhsd->bhts', qj, decay, kj)
        o = (jnp.einsum('bhts,bhsv->bhtv', scores, vj)
             + jnp.einsum('bhtd,bhdv->bhtv', qj * jnp.exp(b), state))
        b_last = b[:, :, -1:, :]
        state = (jnp.exp(b_last[:, :, 0, :])[..., None] * state
                 + jnp.einsum('bhsd,bhsv->bhdv', kj * jnp.exp(b_last - b), vj))
        return state, o

    state0 = jnp.zeros((bsz, A_HEADS, A_DK, A_DV), f32)
    _, o = lax.scan(step, state0, (qc, kc, vc, lfc))
    o = o.transpose(1, 0, 3, 2, 4).reshape(bsz, s_len, A_HEADS, A_DV)
    o = o * lax.rsqrt(jnp.mean(o * o, axis=-1, keepdims=True) + EPS)
    o = o.reshape(bsz, s_len, A_WIDTH) * g_norm.astype(f32) * jax.nn.silu(g.astype(f32))
    return o.astype(dt)


def stick_breaking_attention(q, k, v):
    dt = q.dtype
    bsz, s_len, _ = q.shape
    n_blocks = s_len // SB_BLOCK
    scale = B_DIM ** -0.5

    def heads(t):
        return t.reshape(bsz, s_len, B_HEADS, B_DIM).transpose(0, 2, 1, 3)

    qh, kh, vh = heads(q), heads(k), heads(v)
    q_blocks = qh.reshape(bsz, B_HEADS, n_blocks, SB_BLOCK, B_DIM).transpose(2, 0, 1, 3, 4)
    key_pos = jnp.arange(s_len)

    def one_block(args):
        qi, blk = args
        z = jnp.einsum('bhqd,bhkd->bhqk', qi, kh).astype(jnp.float32) * scale
        t_pos = blk * SB_BLOCK + jnp.arange(SB_BLOCK)
        causal = key_pos[None, :] < t_pos[:, None]
        log_beta = jax.nn.log_sigmoid(z)
        log_keep = jnp.where(causal, jax.nn.log_sigmoid(-z), 0.0)
        suffix = lax.cumsum(log_keep, axis=3, reverse=True) - log_keep
        attn = jnp.where(causal, jnp.exp(log_beta + suffix), 0.0)
        return jnp.einsum('bhqk,bhkd->bhqd', attn.astype(vh.dtype), vh)

    o = lax.map(one_block, (q_blocks, jnp.arange(n_blocks)))
    o = o.transpose(1, 0, 3, 2, 4).reshape(bsz, s_len, B_WIDTH)
    return o.astype(dt)


def chunked_gmlp(h, ln_g, ln_b, ws, bs):
    bsz, s_len, _ = h.shape
    z = jax.nn.gelu(h, approximate=False)
    u, v = z[..., :C_HALF], z[..., C_HALF:]
    v = layer_norm(v, ln_g, ln_b)
    v = v.reshape(bsz, s_len // C_CHUNK, C_CHUNK, C_GROUPS, C_GROUP_DIM)
    w = ws * jnp.tril(jnp.ones((C_CHUNK, C_CHUNK), dtype=ws.dtype))[None]
    mixed = jnp.einsum('gts,bnsgc->bntgc', w, v) + bs.T[None, None, :, :, None]
    return u * mixed.reshape(bsz, s_len, C_HALF)


def setup_inputs(seed: int = 0) -> dict:
    key = jax.random.key(seed)
    ks = jax.random.split(key, 16)
    nrm = jax.random.normal
    f32 = jnp.float32
    return {
        "x": nrm(ks[0], (BATCH, SEQ, D_MODEL), f32),
        "mix_norm": 1.0 + 0.02 * nrm(ks[1], (DEPTH, D_MODEL), f32),
        "mlp_norm": 1.0 + 0.02 * nrm(ks[2], (DEPTH, D_MODEL), f32),
        "mlp_w1": nrm(ks[3], (DEPTH, D_MODEL, MLP_HIDDEN), f32) * D_MODEL ** -0.5,
        "mlp_w2": nrm(ks[4], (DEPTH, MLP_HIDDEN, D_MODEL), f32) * MLP_HIDDEN ** -0.5,
        "ab_w_in": nrm(ks[5], (N_EVEN, D_MODEL, AB_IN), f32) * D_MODEL ** -0.5,
        "ab_w_out": nrm(ks[6], (N_EVEN, AB_MIX, D_MODEL), f32) * AB_MIX ** -0.5,
        "hgrn_lb_logits": nrm(ks[7], (N_EVEN, A_WIDTH), f32),
        "hgrn_out_norm": 1.0 + 0.02 * nrm(ks[8], (N_EVEN, A_WIDTH), f32),
        "gm_w_in": nrm(ks[9], (N_ODD, D_MODEL, C_FFN), f32) * D_MODEL ** -0.5,
        "gm_ln_g": 1.0 + 0.02 * nrm(ks[10], (N_ODD, C_HALF), f32),
        "gm_ln_b": 0.02 * nrm(ks[11], (N_ODD, C_HALF), f32),
        "gm_ws": nrm(ks[12], (N_ODD, C_GROUPS, C_CHUNK, C_CHUNK), f32) * C_CHUNK ** -0.5,
        "gm_bs": 1.0 + 0.02 * nrm(ks[13], (N_ODD, C_GROUPS, C_CHUNK), f32),
        "gm_w_out": nrm(ks[14], (N_ODD, C_HALF, D_MODEL), f32) * C_HALF ** -0.5,
        "final_norm": 1.0 + 0.02 * nrm(ks[15], (D_MODEL,), f32),
    }


def reference(x, mix_norm, mlp_norm, mlp_w1, mlp_w2, ab_w_in, ab_w_out,
              hgrn_lb_logits, hgrn_out_norm, gm_w_in, gm_ln_g, gm_ln_b, gm_ws,
              gm_bs, gm_w_out, final_norm):
    lb_cum = jnp.cumsum(jax.nn.softmax(hgrn_lb_logits.astype(jnp.float32), axis=0), axis=0)
    lower_bounds = lb_cum - lb_cum[0:1]
    splits = [int(s) for s in np.cumsum([A_WIDTH] * 4 + [B_WIDTH] * 3)[:-1]]

    for layer in range(DEPTH):
        h = rms_norm(x, mix_norm[layer])
        if layer % 2 == 0:
            e = layer // 2
            proj = h @ ab_w_in[e]
            qa, fa, ia, ga, qb, kb, vb = jnp.split(proj, splits, axis=-1)
            oa = hgrn2_mix(qa, fa, ia, ga, lower_bounds[e], hgrn_out_norm[e])
            ob = stick_breaking_attention(qb, kb, vb)
            mix = jnp.concatenate([oa, ob], axis=-1) @ ab_w_out[e]
        else:
            o = layer // 2
            gated = chunked_gmlp(h @ gm_w_in[o], gm_ln_g[o], gm_ln_b[o], gm_ws[o], gm_bs[o])
            mix = gated @ gm_w_out[o]
        x = x + mix
        h = rms_norm(x, mlp_norm[layer])
        x = x + jnp.square(jax.nn.relu(h @ mlp_w1[layer])) @ mlp_w2[layer]

    return rms_norm(x, final_norm)
```

```cpp
#ifndef PROBE
#define PROBE 0
#endif
#include <hip/hip_runtime.h>
#include <hip/hip_cooperative_groups.h>
#include <cstdio>
#include <cstdint>
namespace cg = cooperative_groups;
namespace pg8 {
#define PG8_LAS __attribute__((address_space(3)))
typedef unsigned short bf16_t;
typedef short bf16x8 __attribute__((ext_vector_type(8)));
typedef float f32x4 __attribute__((ext_vector_type(4)));
typedef unsigned u32x4 __attribute__((ext_vector_type(4)));
constexpr int BM = 256, BK = 64, HALF = 128, HTB = HALF * BK * 2  , STAGE_BYTES = 8 * HTB, NXCD = 8, WGM = 8;

__host__ __device__ __forceinline__ int lds_byte(int r, int c) { const int st = (r >> 4) * 2 + (c >> 5), rr = r & 15, cc = c & 31, ob = rr * 64 + cc * 2; return st * 1024 + (ob ^ (((ob >> 9) & 1) << 5)); }
__host__ __device__ __forceinline__ void stage_rc(int b, int& R, int& C) { const int st = b / 1024, sb = b % 1024, swz = sb ^ (((sb >> 9) & 1) << 5); R = (st >> 1) * 16 + swz / 64; C = (st & 1) * 32 + (swz % 64) / 2; }
__host__ __device__ __forceinline__ int perm32(int rho) { const int n = rho >> 4, i = rho & 15; return 8 * (i >> 2) + 4 * n + (i & 3); }

struct Unit { int pm, pn, ord; };
struct Gemm { const bf16_t* A; const bf16_t* Bt; int M, N, K; };

struct StaticOrder {
    int nM, nN, nwg, G, c;
    __host__ __device__ void init(int M, int N, int G_, int c_) { nM = M / BM; nN = N / BM; nwg = nM * nN; G = G_; c = c_; }
    __host__ __device__ bool next(int i, Unit& u) const {
        const long L = (long)i * G + c; if (L >= nwg) return false;
        int wgid = (int)L; { const int q = nwg / NXCD, r = nwg % NXCD, xcd = wgid % NXCD, off = wgid / NXCD; wgid = (xcd < r ? xcd * (q + 1) : r * (q + 1) + (xcd - r) * q) + off; }
        const int nig = WGM * nN, gid = wgid / nig, fm = gid * WGM, gsz = (nM - fm) < WGM ? (nM - fm) : WGM;
        u.pm = fm + ((wgid % nig) % gsz); u.pn = (wgid % nig) / gsz; u.ord = i; return true;
    }
    __device__ __forceinline__ void a_ready(const Unit&) const {}
    __device__ __forceinline__ void done(const Unit&) const {}
};

__device__ __forceinline__ unsigned cvt_pk_bf16(float lo, float hi) { unsigned r; asm volatile("v_cvt_pk_bf16_f32 %0, %1, %2" : "=v"(r) : "v"(lo), "v"(hi)); return r; }
typedef float f32x2 __attribute__((ext_vector_type(2)));
__device__ __forceinline__ f32x2 gelu_pk(f32x2 v) {
    const f32x2 av = __builtin_elementwise_abs(v), d = av * 0.2316418882f + 1.0f;
    f32x2 t; t.x = __builtin_amdgcn_rcpf(d.x); t.y = __builtin_amdgcn_rcpf(d.y);
    f32x2 q = t * 0.5307027145f + (-0.7265760135f); q = q * t + 0.7107068705f; q = q * t + (-0.142248368f); q = q * t + 0.127414796f; q = q * t;
    const f32x2 s = (v * v) * (-0.72134752044f);
    f32x2 e; e.x = __builtin_amdgcn_exp2f(s.x); e.y = __builtin_amdgcn_exp2f(s.y);
    const f32x2 m = v * (q * e), r = v - m;
    f32x2 o; o.x = v.x < 0.f ? m.x : r.x; o.y = v.y < 0.f ? m.y : r.y; return o;
}
typedef unsigned u32x2 __attribute__((ext_vector_type(2)));
__device__ __forceinline__ float rstd1024(const float* s16) { const f32x4 a = *(const f32x4*)s16, b = *(const f32x4*)(s16 + 4), c = *(const f32x4*)(s16 + 8), d = *(const f32x4*)(s16 + 12);
    const float t = (((a[0] + a[1]) + (a[2] + a[3])) + ((b[0] + b[1]) + (b[2] + b[3]))) + (((c[0] + c[1]) + (c[2] + c[3])) + ((d[0] + d[1]) + (d[2] + d[3])));
    return __builtin_amdgcn_rsqf(t * (1.0f / 1024.0f) + 1e-6f); }
__device__ __forceinline__ float sigm(float v) { return __builtin_amdgcn_rcpf(1.0f + __expf(-v)); }
__device__ __forceinline__ u32x4 pack8(const f32x4& a, const f32x4& b) { u32x4 w; w.x = cvt_pk_bf16(a[0], a[1]); w.y = cvt_pk_bf16(a[2], a[3]); w.z = cvt_pk_bf16(b[0], b[1]); w.w = cvt_pk_bf16(b[2], b[3]); return w; }

struct EpiProj {
    static constexpr bool PERM = true, AFTER_DRAIN = false, IDEMP = true;
    const PG8_LAS float* rst; const float* lb; const float* gnorm; bf16_t* QAB; bf16_t* KA; float* LF; bf16_t* GA; bf16_t* KB; int seg0;
    __device__ __forceinline__ void operator()(const f32x4 (&acc)[2][2][4][2], const Unit& u, int wr, int wc, int fr, int fq) const {
        asm volatile("" : "+v"(fr), "+v"(fq));
        const int seg = seg0 + (u.pn >> 1);
        const int cb = (u.pn & 1) * 256 + wc * 32 + 8 * fq;
#pragma unroll
        for (int ai = 0; ai < 2; ++ai)
#pragma unroll
            for (int m = 0; m < 4; ++m) {
                const size_t row = (size_t)u.pm * BM + ai * HALF + wr * 64 + m * 16 + fr;
                const float rs = rst[u.ord * 256 + ai * HALF + wr * 64 + m * 16 + fr];
#pragma unroll
                for (int bj = 0; bj < 2; ++bj) {
                    const int c = cb + bj * HALF;
                    f32x4 v0 = acc[ai][bj][m][0] * rs, v1 = acc[ai][bj][m][1] * rs;
                    if (seg == 0) {
#pragma unroll
                        for (int e = 0; e < 4; ++e) { v0[e] = v0[e] * sigm(v0[e]); v1[e] = v1[e] * sigm(v1[e]); }
                        *(u32x4*)(QAB + row * 1024 + c) = pack8(v0, v1);
                    } else if (seg == 1) {
                        const f32x4 l0 = *(const f32x4*)(lb + c), l1 = *(const f32x4*)(lb + c + 4);
                        f32x4 lf0, lf1, k0, k1;
#pragma unroll
                        for (int e = 0; e < 4; ++e) {
                            const float s0 = sigm(v0[e]), s1 = sigm(v1[e]);
                            lf0[e] = __logf(l0[e] + (1.0f - l0[e]) * s0); lf1[e] = __logf(l1[e] + (1.0f - l1[e]) * s1);
                            k0[e] = (1.0f - l0[e]) * sigm(-v0[e]); k1[e] = (1.0f - l1[e]) * sigm(-v1[e]);
                        }
                        *(f32x4*)(LF + row * 512 + c) = lf0; *(f32x4*)(LF + row * 512 + c + 4) = lf1;
                        *(u32x4*)(KA + row * 512 + c) = pack8(k0, k1);
                    } else if (seg == 4) {
                        const f32x4 g0 = *(const f32x4*)(gnorm + c), g1 = *(const f32x4*)(gnorm + c + 4);
#pragma unroll
                        for (int e = 0; e < 4; ++e) { v0[e] = g0[e] * v0[e] * sigm(v0[e]); v1[e] = g1[e] * v1[e] * sigm(v1[e]); }
                        *(u32x4*)(GA + row * 512 + c) = pack8(v0, v1);
                    } else if (seg == 2) {
                        v0 = v0 * 0.08838834764831845f; v1 = v1 * 0.08838834764831845f;
                        *(u32x4*)(QAB + row * 1024 + 512 + c) = pack8(v0, v1);
                    } else {
                        *(u32x4*)(KB + row * 512 + c) = pack8(v0, v1);
                    }
                }
                asm volatile("" ::: "memory");
            }
    }
};

template <int ACT> struct EpiRow {
    static constexpr bool PERM = true, AFTER_DRAIN = false, IDEMP = true;
    const PG8_LAS float* rst; bf16_t* O; int ldc;
    __device__ __forceinline__ void operator()(const f32x4 (&acc)[2][2][4][2], const Unit& u, int wr, int wc, int fr, int fq) const {
        asm volatile("" : "+v"(fr), "+v"(fq));
        bf16_t* base = O + (size_t)u.pm * BM * ldc + u.pn * BM; const PG8_LAS float* sb = rst + u.ord * 256;
        const unsigned r0 = wr * 64 + fr, c0 = wc * 32 + 8 * fq;
#pragma unroll
        for (int ai = 0; ai < 2; ++ai)
#pragma unroll
            for (int m = 0; m < 4; ++m) {
                const unsigned row = r0 + ai * HALF + m * 16;
                const float rs = sb[row];
#pragma unroll
                for (int bj = 0; bj < 2; ++bj) {
                    f32x4 v0 = acc[ai][bj][m][0] * rs, v1 = acc[ai][bj][m][1] * rs;
                    if (ACT == 1) { f32x2 a = gelu_pk((f32x2){v0[0], v0[1]}), b = gelu_pk((f32x2){v0[2], v0[3]}), c = gelu_pk((f32x2){v1[0], v1[1]}), d = gelu_pk((f32x2){v1[2], v1[3]});
                        v0 = (f32x4){a.x, a.y, b.x, b.y}; v1 = (f32x4){c.x, c.y, d.x, d.y}; }
                    else {
#pragma unroll
                        for (int e = 0; e < 4; ++e) { const float a = fmaxf(v0[e], 0.f), b = fmaxf(v1[e], 0.f); v0[e] = a * a; v1[e] = b * b; } }
                    *(u32x4*)(base + row * (unsigned)ldc + c0 + bj * HALF) = pack8(v0, v1);
                }
                asm volatile("" ::: "memory");
            }
    }
};

template <int ACT> struct EpiT {
    static constexpr bool PERM = true, AFTER_DRAIN = false, IDEMP = true;
    const PG8_LAS float* rst; bf16_t* O; int nch; float* s1; float* s2;
    __device__ __forceinline__ void operator()(const f32x4 (&acc)[2][2][4][2], const Unit& u, int wr, int wc, int fr, int fq) const {
        asm volatile("" : "+v"(fr), "+v"(fq));
        const int tb = u.pn * BM + wc * 32 + 8 * fq;
        f32x4 rs[2][2];
#pragma unroll
        for (int bj = 0; bj < 2; ++bj)
#pragma unroll
            for (int n = 0; n < 2; ++n) rs[bj][n] = *(const PG8_LAS f32x4*)(rst + u.ord * 256 + wc * 32 + 8 * fq + bj * HALF + 4 * n);
        bf16_t* ob = O + ((size_t)(u.pn * 2) * nch + u.pm * BM) * 128 + wc * 32 + 8 * fq;
        f32x4 a1[2][2], a2[2][2];
#pragma unroll
        for (int bj = 0; bj < 2; ++bj)
#pragma unroll
            for (int n = 0; n < 2; ++n) { a1[bj][n] = (f32x4){0.f, 0.f, 0.f, 0.f}; a2[bj][n] = (f32x4){0.f, 0.f, 0.f, 0.f}; }
#pragma unroll
        for (int ai = 0; ai < 2; ++ai)
#pragma unroll
            for (int m = 0; m < 4; ++m) {
                const unsigned row = ai * HALF + wr * 64 + m * 16 + fr;
#pragma unroll
                for (int bj = 0; bj < 2; ++bj) {
                    f32x4 v0 = acc[ai][bj][m][0] * rs[bj][0], v1 = acc[ai][bj][m][1] * rs[bj][1];
                    if (ACT == 1) { f32x2 a = gelu_pk((f32x2){v0[0], v0[1]}), b = gelu_pk((f32x2){v0[2], v0[3]}), c = gelu_pk((f32x2){v1[0], v1[1]}), d = gelu_pk((f32x2){v1[2], v1[3]});
                        v0 = (f32x4){a.x, a.y, b.x, b.y}; v1 = (f32x4){c.x, c.y, d.x, d.y};
                        a1[bj][0] += v0; a1[bj][1] += v1; a2[bj][0] += v0 * v0; a2[bj][1] += v1 * v1; }
                    *(u32x4*)(ob + ((unsigned)bj * (unsigned)nch + row) * 128u) = pack8(v0, v1);
                }
                asm volatile("" ::: "memory");
            }
        if (ACT == 1) {
#pragma unroll
            for (int bj = 0; bj < 2; ++bj)
#pragma unroll
                for (int n = 0; n < 2; ++n)
#pragma unroll
                    for (int e = 0; e < 4; ++e) {
                        float x = a1[bj][n][e], y = a2[bj][n][e];
#pragma unroll
                        for (int o = 1; o < 16; o <<= 1) { x += __shfl_xor(x, o); y += __shfl_xor(y, o); }
                        if (fr == 0) { const size_t sl = (size_t)(tb + bj * HALF + 4 * n + e) * 24 + u.pm * 2 + wr; s1[sl] = x; s2[sl] = y; }
                    }
        }
    }
};

struct EpiRes {
    static constexpr bool PERM = true, AFTER_DRAIN = false, IDEMP = false;
    bf16_t* XB; float* ssq_next;
    __device__ __forceinline__ void operator()(const f32x4 (&acc)[2][2][4][2], const Unit& u, int wr, int wc, int fr, int fq) const {
        asm volatile("" : "+v"(fr), "+v"(fq));
        const int cb = u.pn * BM + wc * 32 + 8 * fq;
#pragma unroll
        for (int ai = 0; ai < 2; ++ai)
#pragma unroll
            for (int m = 0; m < 4; ++m) {
                const size_t row = (size_t)u.pm * BM + ai * HALF + wr * 64 + m * 16 + fr;
                float part = 0.f;
#pragma unroll
                for (int bj = 0; bj < 2; ++bj) {
                    const size_t off = row * 1024 + cb + bj * HALF;
                    const u32x4 xo = *(const u32x4*)(XB + off);
                    f32x4 x0, x1;
                    x0[0] = __uint_as_float(xo.x << 16); x0[1] = __uint_as_float(xo.x & 0xffff0000u); x0[2] = __uint_as_float(xo.y << 16); x0[3] = __uint_as_float(xo.y & 0xffff0000u);
                    x1[0] = __uint_as_float(xo.z << 16); x1[1] = __uint_as_float(xo.z & 0xffff0000u); x1[2] = __uint_as_float(xo.w << 16); x1[3] = __uint_as_float(xo.w & 0xffff0000u);
                    x0 += acc[ai][bj][m][0]; x1 += acc[ai][bj][m][1];
                    const u32x4 w = pack8(x0, x1);
                    *(u32x4*)(XB + off) = w;
                    x0[0] = __uint_as_float(w.x << 16); x0[1] = __uint_as_float(w.x & 0xffff0000u); x0[2] = __uint_as_float(w.y << 16); x0[3] = __uint_as_float(w.y & 0xffff0000u);
                    x1[0] = __uint_as_float(w.z << 16); x1[1] = __uint_as_float(w.z & 0xffff0000u); x1[2] = __uint_as_float(w.w << 16); x1[3] = __uint_as_float(w.w & 0xffff0000u);
                    part += ((x0[0] * x0[0] + x0[1] * x0[1]) + (x0[2] * x0[2] + x0[3] * x0[3])) + ((x1[0] * x1[0] + x1[1] * x1[1]) + (x1[2] * x1[2] + x1[3] * x1[3]));
                }
                part += __shfl_xor(part, 16); part += __shfl_xor(part, 32);
                if (fq == 0) ssq_next[row * 16 + u.pn * 4 + wc] = part;
            }
    }
};

template <class Epi, class Sched, bool ALIGN_EPI = false, bool SP2 = false>
__device__ __forceinline__ void gemm_phase(PG8_LAS unsigned char* lds, const Gemm g, const Sched& S, const Epi& E) {
    int tid_ = threadIdx.x; asm volatile("" : "+v"(tid_), "+s"(lds));
    const int tid = tid_, wid = __builtin_amdgcn_readfirstlane(tid >> 6), lane = tid & 63, wr = wid >> 2, wc = wid & 3, fr = lane & 15, fq = lane >> 4;
    const bf16_t* gA = g.A; const bf16_t* gBt = g.Bt; asm volatile("" : "+s"(gA), "+s"(gBt));
    const int K = g.K, nt = K / BK;
    unsigned voffA[2], voffB[2];
#pragma unroll
    for (int i = 0; i < 2; ++i) { int R, C; stage_rc(tid * 16 + i * 8192, R, C); const int Rb = Epi::PERM ? ((R & ~31) + perm32(R & 31)) : R;
        voffA[i] = (unsigned)(R * K + C) * 2u; voffB[i] = (unsigned)(Rb * K + C) * 2u; }
    const size_t kstep = (size_t)(BK * 2);
    const size_t hstep = (size_t)HALF * K * 2;
    const size_t tstep = 2 * hstep;
    const unsigned ldsw = (unsigned)wid * 1024u;
    const int aoff = lds_byte(wr * 64 + fr, fq * 8), boff = lds_byte(wc * 32 + fr, fq * 8);
#define PG8_SA(b, h) (((b) * 2 + (h)) * HTB)
#define PG8_SB(b, h) ((4 + (b) * 2 + (h)) * HTB)
#define PG8_STAGE(bufoff, gbase, voff) do { _Pragma("unroll") for (int _i = 0; _i < 2; ++_i) \
        __builtin_amdgcn_global_load_lds((const unsigned*)((const char*)(gbase) + (voff)[_i]), (PG8_LAS unsigned*)(lds + (bufoff) + ldsw + _i * 8192), 16, 0, 0); } while (0)
#define PG8_LDA(dst, b, h) do { _Pragma("unroll") for (int m = 0; m < 4; ++m) _Pragma("unroll") for (int k = 0; k < 2; ++k) dst[m][k] = *(const PG8_LAS bf16x8*)(lds + PG8_SA(b, h) + aoff + m * 2048 + k * 1024); } while (0)
#define PG8_LDB(dst, b, h) do { _Pragma("unroll") for (int n = 0; n < 2; ++n) _Pragma("unroll") for (int k = 0; k < 2; ++k) dst[n][k] = *(const PG8_LAS bf16x8*)(lds + PG8_SB(b, h) + boff + n * 2048 + k * 1024); } while (0)
#define PG8_MMA(ai, bj, At, Bt) do { __builtin_amdgcn_s_setprio(1); _Pragma("unroll") for (int m = 0; m < 4; ++m) _Pragma("unroll") for (int n = 0; n < 2; ++n) _Pragma("unroll") for (int k = 0; k < 2; ++k) \
        acc[ai][bj][m][n] = __builtin_amdgcn_mfma_f32_16x16x32_bf16(Bt[n][k], At[m][k], acc[ai][bj][m][n], 0, 0, 0); __builtin_amdgcn_s_setprio(0); } while (0)
#define PG8_WAIT_V(n) asm volatile("s_waitcnt vmcnt(" #n ")" ::: "memory")
#define PG8_WAIT_L(n) asm volatile("s_waitcnt lgkmcnt(" #n ")" ::: "memory")
#define PG8_BAR __builtin_amdgcn_s_barrier()
#define PG8_SCHED __builtin_amdgcn_sched_barrier(0)
    Unit cur, nxt; int ui = 0;
    if (!S.next(0, cur)) return;
    f32x4 acc[2][2][4][2];
#pragma unroll
    for (int a = 0; a < 2; ++a)
#pragma unroll
        for (int b = 0; b < 2; ++b)
#pragma unroll
            for (int m = 0; m < 4; ++m)
#pragma unroll
                for (int n = 0; n < 2; ++n) acc[a][b][m][n] = (f32x4){0.f, 0.f, 0.f, 0.f};
    bf16x8 At[4][2], B0[2][2], B1[2][2];
    const char* cA = (const char*)gA + (size_t)cur.pm * tstep; const char* cB = (const char*)gBt + (size_t)cur.pn * tstep;
    S.a_ready(cur);
    if constexpr (SP2) {
        PG8_STAGE(PG8_SB(0, 0), cB, voffB); PG8_STAGE(PG8_SB(0, 1), cB + hstep, voffB); PG8_STAGE(PG8_SA(0, 0), cA, voffA); PG8_STAGE(PG8_SA(0, 1), cA + hstep, voffA);
        if (wr == 1) PG8_BAR;
        PG8_WAIT_V(2); PG8_BAR;
        PG8_STAGE(PG8_SB(1, 0), cB + kstep, voffB); PG8_STAGE(PG8_SA(1, 0), cA + kstep, voffA); PG8_STAGE(PG8_SB(1, 1), cB + hstep + kstep, voffB);
        PG8_WAIT_V(6); PG8_BAR;
    } else {
        PG8_STAGE(PG8_SB(0, 0), cB, voffB); PG8_STAGE(PG8_SA(0, 0), cA, voffA); PG8_STAGE(PG8_SB(0, 1), cB + hstep, voffB); PG8_STAGE(PG8_SA(0, 1), cA + hstep, voffA);
        if (wr == 1) PG8_BAR;
        PG8_WAIT_V(4); PG8_BAR;
        PG8_STAGE(PG8_SB(1, 0), cB + kstep, voffB); PG8_STAGE(PG8_SA(1, 0), cA + kstep, voffA); PG8_STAGE(PG8_SB(1, 1), cB + hstep + kstep, voffB);
        PG8_WAIT_V(6); PG8_BAR;
    }
    for (;;) {
        const bool has_next = S.next(ui + 1, nxt);
        const char* nA = has_next ? (const char*)gA + (size_t)nxt.pm * tstep : cA; const char* nB = has_next ? (const char*)gBt + (size_t)nxt.pn * tstep : cB;
        for (int t = 0; t < nt; t += 2) {
            const bool last = (t == nt - 2);
            const char* a1 = cA + (size_t)(t + 1) * kstep;
            const char* a2 = last ? nA : cA + (size_t)(t + 2) * kstep; const char* b2 = last ? nB : cB + (size_t)(t + 2) * kstep;
            const char* a3 = a2 + kstep; const char* b3 = b2 + kstep;
            if (last && has_next) S.a_ready(nxt);
            if constexpr (SP2) {
            PG8_LDB(B0, 0, 0); PG8_LDB(B1, 0, 1); PG8_SCHED; PG8_LDA(At, 0, 0); PG8_STAGE(PG8_SA(1, 1), a1 + hstep, voffA);
            PG8_WAIT_V(8); PG8_WAIT_L(0); PG8_BAR; PG8_MMA(0, 0, At, B0); PG8_MMA(0, 1, At, B1); PG8_BAR; PG8_SCHED;
            PG8_LDA(At, 0, 1); PG8_STAGE(PG8_SB(0, 0), b2, voffB); PG8_STAGE(PG8_SB(0, 1), b2 + hstep, voffB); PG8_STAGE(PG8_SA(0, 0), a2, voffA);
            PG8_WAIT_V(8); PG8_WAIT_L(0); PG8_BAR; PG8_MMA(1, 0, At, B0); PG8_MMA(1, 1, At, B1); PG8_BAR; PG8_SCHED;
            PG8_LDB(B0, 1, 0); PG8_LDB(B1, 1, 1); PG8_SCHED; PG8_LDA(At, 1, 0); PG8_STAGE(PG8_SA(0, 1), a2 + hstep, voffA);
            PG8_WAIT_V(8); PG8_WAIT_L(0); PG8_BAR; PG8_MMA(0, 0, At, B0); PG8_MMA(0, 1, At, B1); PG8_BAR; PG8_SCHED;
            PG8_LDA(At, 1, 1); PG8_STAGE(PG8_SB(1, 0), b3, voffB); PG8_STAGE(PG8_SB(1, 1), b3 + hstep, voffB); PG8_STAGE(PG8_SA(1, 0), a3, voffA);
            PG8_WAIT_V(8); PG8_WAIT_L(0); PG8_BAR; PG8_MMA(1, 0, At, B0); PG8_MMA(1, 1, At, B1); PG8_BAR; PG8_SCHED;
            } else {
            PG8_LDB(B0, 0, 0); PG8_SCHED; PG8_LDA(At, 0, 0); PG8_STAGE(PG8_SA(1, 1), a1 + hstep, voffA);
            PG8_WAIT_L(8); PG8_BAR; PG8_WAIT_L(0); PG8_MMA(0, 0, At, B0); PG8_BAR; PG8_SCHED;
            PG8_LDB(B1, 0, 1); PG8_STAGE(PG8_SB(0, 0), b2, voffB);
            PG8_BAR; PG8_WAIT_L(0); PG8_MMA(0, 1, At, B1); PG8_BAR;
            PG8_LDA(At, 0, 1); PG8_STAGE(PG8_SA(0, 0), a2, voffA);
            PG8_BAR; PG8_WAIT_L(0); PG8_MMA(1, 0, At, B0); PG8_BAR; PG8_SCHED;
            PG8_STAGE(PG8_SB(0, 1), b2 + hstep, voffB);
            PG8_WAIT_V(6); PG8_BAR; PG8_MMA(1, 1, At, B1); PG8_BAR;
            PG8_LDB(B0, 1, 0); PG8_SCHED; PG8_LDA(At, 1, 0); PG8_STAGE(PG8_SA(0, 1), a2 + hstep, voffA);
            PG8_WAIT_L(8); PG8_BAR; PG8_WAIT_L(0); PG8_MMA(0, 0, At, B0); PG8_BAR; PG8_SCHED;
            PG8_LDB(B1, 1, 1); PG8_STAGE(PG8_SB(1, 0), b3, voffB);
            PG8_BAR; PG8_WAIT_L(0); PG8_MMA(0, 1, At, B1); PG8_BAR;
            PG8_LDA(At, 1, 1); PG8_STAGE(PG8_SA(1, 0), a3, voffA);
            PG8_BAR; PG8_WAIT_L(0); PG8_MMA(1, 0, At, B0); PG8_BAR; PG8_SCHED;
            PG8_STAGE(PG8_SB(1, 1), b3 + hstep, voffB);
            PG8_WAIT_V(6); PG8_BAR; PG8_MMA(1, 1, At, B1); PG8_BAR;
            }
        }
        if constexpr (ALIGN_EPI) { if (wr == 0) PG8_BAR; }
        if constexpr (!Epi::AFTER_DRAIN) { E(acc, cur, wr, wc, fr, fq);
#if defined(PROBE) && (PROBE & 128)
            if constexpr (Epi::IDEMP) E(acc, cur, wr, wc, fr, fq);
#endif
            S.done(cur); }
        if (!has_next) break;
#pragma unroll
        for (int a = 0; a < 2; ++a)
#pragma unroll
            for (int b = 0; b < 2; ++b)
#pragma unroll
                for (int m = 0; m < 4; ++m)
#pragma unroll
                    for (int n = 0; n < 2; ++n) acc[a][b][m][n] = (f32x4){0.f, 0.f, 0.f, 0.f};
        cur = nxt; cA = nA; cB = nB; ++ui;
        if constexpr (ALIGN_EPI) { if (wr == 1) PG8_BAR; }
    }
    PG8_WAIT_V(0);
    if constexpr (!ALIGN_EPI) { if (wr == 0) PG8_BAR; }
    PG8_BAR;
    if constexpr (Epi::AFTER_DRAIN) { E.fused(acc, cur, wr, wc, fr, fq, lds, wid, lane); S.done(cur); }
#undef PG8_SA
#undef PG8_SB
#undef PG8_STAGE
#undef PG8_LDA
#undef PG8_LDB
#undef PG8_MMA
#undef PG8_WAIT_V
#undef PG8_WAIT_L
#undef PG8_BAR
#undef PG8_SCHED
}
}

#define LAS __attribute__((address_space(3)))
using pg8::bf16_t; using pg8::bf16x8; using pg8::f32x4; using pg8::u32x4; using pg8::u32x2; using pg8::f32x2;
constexpr int M = 16384, D = 1024, SEQ = 4096;
constexpr int NWAVES = 8, NTHREADS = 512;
constexpr int LDS_BYTES = 147456;
constexpr size_t MiB = 1u << 20;
constexpr size_t WS_STAT = 0, OFF_LB = 0;
constexpr size_t WS_WA = 1 * MiB, WS_WB = 7 * MiB, WS_WO = 13 * MiB, WS_W1 = 19 * MiB, WS_W2 = 27 * MiB;
constexpr size_t WS_XB = 35 * MiB;
constexpr size_t WS_ACT = 67 * MiB;
constexpr size_t WS_QAB = WS_ACT, WS_KA = WS_ACT + 32 * MiB, WS_GA = WS_ACT + 48 * MiB, WS_KB = WS_ACT + 64 * MiB, WS_VB = WS_ACT + 80 * MiB, WS_LF = WS_ACT + 96 * MiB, WS_IAT = WS_ACT + 128 * MiB;
constexpr size_t WS_ST = WS_ACT + 160 * MiB;
constexpr size_t WS_H = WS_ACT;
constexpr size_t WS_U = WS_ACT, WS_VT = WS_ACT + 96 * MiB;
constexpr size_t WS_SSQ = WS_VT + 96 * MiB;
constexpr size_t WS_LNP = WS_SSQ + 9 * MiB;
constexpr size_t LNP_STRIDE = (size_t)M * 24 * 4;
constexpr size_t WS_END = WS_LNP + 6 * MiB;

__device__ __forceinline__ unsigned f2bf(float f) { unsigned u = __float_as_uint(f); return (u + 0x7fffu + ((u >> 16) & 1u)) >> 16; }
__device__ __forceinline__ unsigned pk2(float lo, float hi) { return f2bf(lo) | (f2bf(hi) << 16); }
__device__ __forceinline__ float bflo(unsigned u) { return __uint_as_float(u << 16); }
__device__ __forceinline__ float bfhi(unsigned u) { return __uint_as_float(u & 0xffff0000u); }
__device__ __forceinline__ float wave_sum(float v) {
#pragma unroll
    for (int o = 1; o < 64; o <<= 1) v += __shfl_xor(v, o);
    return v;
}

struct Params { const float* in[16]; float* out; unsigned char* ws; int ph_lo, ph_hi; };
enum { I_X = 0, I_MIXN, I_MLPN, I_W1, I_W2, I_ABIN, I_ABOUT, I_LBL, I_HON, I_GMIN, I_LNG, I_LNB, I_GMWS, I_GMBS, I_GMOUT, I_FN };

__device__ __forceinline__ void conv_seg(const float* W, int ldw, int col0, int ncols, int K, const float* gain, bf16_t* WT, int row_off, LAS float* scr, int gw, int ngw, int lane) {
    const int nblk = ncols / 32, nitems = (K / 64) * nblk;
    int it = gw; if (it >= nitems) return;
    const int k8 = lane >> 3, n4 = lane & 7;
    f32x4 cur[8];
    { const int kb = it / nblk, nb = it % nblk; const float* src = W + (size_t)(64 * kb + k8) * ldw + col0 + 32 * nb + 4 * n4;
#pragma unroll
      for (int i = 0; i < 8; ++i) cur[i] = *(const f32x4*)(src + (size_t)(8 * i) * ldw); }
    for (;;) {
        const int nx = it + ngw; const bool has = nx < nitems;
        f32x4 nxt[8];
        if (has) { const int kb = nx / nblk, nb = nx % nblk; const float* src = W + (size_t)(64 * kb + k8) * ldw + col0 + 32 * nb + 4 * n4;
#pragma unroll
            for (int i = 0; i < 8; ++i) nxt[i] = *(const f32x4*)(src + (size_t)(8 * i) * ldw); }
        const int kb = it / nblk, nb = it % nblk, k0 = 64 * kb, n0 = 32 * nb;
#pragma unroll
        for (int i = 0; i < 8; ++i) { LAS float* d = scr + (8 * i + k8) * 33 + 4 * n4; d[0] = cur[i][0]; d[1] = cur[i][1]; d[2] = cur[i][2]; d[3] = cur[i][3]; }
        asm volatile("s_waitcnt lgkmcnt(0)" ::: "memory");
        const int c = lane & 7;
        f32x4 g0 = (f32x4){1.f, 1.f, 1.f, 1.f}, g1 = g0;
        if (gain) { g0 = *(const f32x4*)(gain + k0 + 8 * c); g1 = *(const f32x4*)(gain + k0 + 8 * c + 4); }
#pragma unroll
        for (int j = 0; j < 4; ++j) { const int n = (lane >> 3) + 8 * j; const LAS float* s = scr + (8 * c) * 33 + n;
            u32x4 o; o.x = pk2(s[0 * 33] * g0[0], s[1 * 33] * g0[1]); o.y = pk2(s[2 * 33] * g0[2], s[3 * 33] * g0[3]); o.z = pk2(s[4 * 33] * g1[0], s[5 * 33] * g1[1]); o.w = pk2(s[6 * 33] * g1[2], s[7 * 33] * g1[3]);
            *(u32x4*)(WT + (size_t)(row_off + n0 + n) * K + k0 + 8 * c) = o; }
        asm volatile("s_waitcnt lgkmcnt(0)" ::: "memory");
        if (!has) break;
#pragma unroll
        for (int i = 0; i < 8; ++i) cur[i] = nxt[i];
        it = nx;
    }
}

__device__ __forceinline__ void conv_chore(const Params& p, int layer, int what, LAS unsigned char* lds, int gw, int ngw, int wave, int lane) {
    if (layer > 3) return;
    LAS float* scr = (LAS float*)(lds + wave * 16384);
    unsigned char* ws = p.ws;
    bf16_t* WA = (bf16_t*)(ws + WS_WA); bf16_t* WB = (bf16_t*)(ws + WS_WB);
    const float* gmix = p.in[I_MIXN] + layer * 1024;
    const int e = layer >> 1; const bool odd = (layer & 1) != 0;
    for (int s = 0; s < 10; ++s) {
        const float* W; int ldw, col0, ncols, K, row_off; const float* gain; bf16_t* WT;
        if (s < 7) {
            if (!(what & 1)) continue;
            if (!odd) { W = p.in[I_ABIN] + (size_t)e * 1024 * 3584; ldw = 3584; col0 = 512 * ((0x6235410 >> (4 * s)) & 15); ncols = 512; K = 1024; gain = gmix; WT = s < 5 ? WA : WB; row_off = s < 5 ? 512 * s : 512 * (s - 5); }
            else { if (s > 1) continue; W = p.in[I_GMIN] + (size_t)e * 1024 * 6144; ldw = 6144; col0 = 3072 * s; ncols = 3072; K = 1024; gain = gmix; WT = s ? WB : WA; row_off = 0; }
        } else if (s == 7) {
            if (!(what & 2)) continue;
            W = odd ? p.in[I_GMOUT] + (size_t)e * 3072 * 1024 : p.in[I_ABOUT] + (size_t)e * 1024 * 1024; ldw = 1024; col0 = 0; ncols = 1024; K = odd ? 3072 : 1024; gain = nullptr; WT = (bf16_t*)(ws + WS_WO); row_off = 0;
        } else if (s == 8) {
            if (!(what & 4)) continue;
            W = p.in[I_W1] + (size_t)layer * 1024 * 4096; ldw = 4096; col0 = 0; ncols = 4096; K = 1024; gain = p.in[I_MLPN] + layer * 1024; WT = (bf16_t*)(ws + WS_W1); row_off = 0;
        } else {
            if (!(what & 8)) continue;
            W = p.in[I_W2] + (size_t)layer * 4096 * 1024; ldw = 1024; col0 = 0; ncols = 1024; K = 4096; gain = nullptr; WT = (bf16_t*)(ws + WS_W2); row_off = 0;
        }
        conv_seg(W, ldw, col0, ncols, K, gain, WT, row_off, scr, gw, ngw, lane);
    }
}

__device__ __forceinline__ bf16x8 frag2(const u32x2 lo, const u32x2 hi) { return __builtin_bit_cast(bf16x8, (u32x4){lo.x, lo.y, hi.x, hi.y}); }
__device__ __forceinline__ u32x2 pack4(const f32x4 v) { u32x2 r; r.x = pk2(v[0], v[1]); r.y = pk2(v[2], v[3]); return r; }
constexpr size_t OFF_DEC = 65536;
template <bool OUT>
__device__ __forceinline__ void hgrn_unit(const Params& p, int unit, LAS unsigned char* lds, int tid, int wave, int lane, bool dummy = false) {
    unsigned char* ws = p.ws;
    const float* LF = (const float*)(ws + WS_LF); const bf16_t* KA = (const bf16_t*)(ws + WS_KA); bf16_t* QAB = (bf16_t*)(ws + WS_QAB); const bf16_t* GA = (const bf16_t*)(ws + WS_GA);
    const bf16_t* IAT = (const bf16_t*)(ws + WS_IAT); float* ST = (float*)(ws + WS_ST); float* DEC = (float*)(ws + OFF_DEC);
    const int bh = unit >> 4, jp = unit & 15, b = bh >> 2, h = bh & 3;
    constexpr int PC = 272, PT = 272;
    LAS unsigned char* Qs = lds; LAS unsigned char* Ks = lds + 128 * PC; LAS unsigned char* KhT = lds + 256 * PC; LAS unsigned char* VTs = KhT + 128 * PT;
    LAS float* DECs = (LAS float*)(VTs + 128 * PT); LAS float* SSQs = DECs + 512;
    const int fr = lane & 15, fq = lane >> 4;
    f32x4 S[8];
    float* stp = ST + ((size_t)unit * 128 + 16 * wave + fr) * 128 + 4 * fq;
#pragma unroll
    for (int dt = 0; dt < 8; ++dt) S[dt] = OUT ? *(const f32x4*)(stp + 16 * dt) : (f32x4){0.f, 0.f, 0.f, 0.f};
    float dprod = 1.f;
    for (int sub = 0; sub < 2; ++sub) {
    const size_t row0 = (size_t)b * SEQ + 128 * (2 * jp + sub);
    f32x4 oacc[4][2];
    __syncthreads();
    {
        u32x4 vt[4];
#pragma unroll
        for (int i = 0; i < 4; ++i) { const int idx = tid + NTHREADS * i; vt[i] = *(const u32x4*)(IAT + ((row0 >> 7) * 1024 + h * 128 + (idx >> 4)) * 128 + (idx & 15) * 8); }
        const int tg = tid & 7, d8 = (tid >> 3) & 15, c = tid >> 7;
        const size_t r0 = row0 + 32 * c + 4 * tg;
        const int ch0 = h * 128 + 8 * d8;
        f32x4 la[4], lb4[4]; u32x4 kr[4], qr[4];
#pragma unroll
        for (int i = 0; i < 4; ++i) { la[i] = *(const f32x4*)(LF + (r0 + i) * 512 + ch0); lb4[i] = *(const f32x4*)(LF + (r0 + i) * 512 + ch0 + 4); kr[i] = *(const u32x4*)(KA + (r0 + i) * 512 + ch0);
            if (OUT) qr[i] = *(const u32x4*)(QAB + (r0 + i) * 1024 + ch0); }
        float bcum[4][8];
#pragma unroll
        for (int e = 0; e < 8; ++e) { float run = 0.f;
#pragma unroll
            for (int i = 0; i < 4; ++i) { run += (e < 4) ? la[i][e & 3] : lb4[i][e & 3]; bcum[i][e] = run; } }
        float excl[8], tot[8];
#pragma unroll
        for (int e = 0; e < 8; ++e) { const float loc = bcum[3][e]; float inc = loc;
#pragma unroll
            for (int o = 1; o < 8; o <<= 1) { const float y = __shfl_up(inc, o, 8); if (tg >= o) inc += y; }
            excl[e] = inc - loc; tot[e] = __shfl(inc, 7, 8); }
        if (tg == 0) { *(LAS f32x4*)(DECs + c * 128 + 8 * d8) = (f32x4){__expf(tot[0]), __expf(tot[1]), __expf(tot[2]), __expf(tot[3])};
                       *(LAS f32x4*)(DECs + c * 128 + 8 * d8 + 4) = (f32x4){__expf(tot[4]), __expf(tot[5]), __expf(tot[6]), __expf(tot[7])}; }
        unsigned khb[4][8];
#pragma unroll
        for (int i = 0; i < 4; ++i) {
            unsigned qw[4], kw[4];
#pragma unroll
            for (int e2 = 0; e2 < 4; ++e2) {
                const float b0 = excl[2 * e2] + bcum[i][2 * e2], b1 = excl[2 * e2 + 1] + bcum[i][2 * e2 + 1];
                const float k0 = bflo(kr[i][e2]), k1 = bfhi(kr[i][e2]);
                khb[i][2 * e2] = f2bf(k0 * __expf(tot[2 * e2] - b0)); khb[i][2 * e2 + 1] = f2bf(k1 * __expf(tot[2 * e2 + 1] - b1));
                if (OUT) { qw[e2] = pk2(bflo(qr[i][e2]) * __expf(b0), bfhi(qr[i][e2]) * __expf(b1)); kw[e2] = pk2(k0 * __expf(-b0), k1 * __expf(-b1)); }
            }
            if (OUT) { *(LAS u32x4*)(Qs + (32 * c + 4 * tg + i) * PC + 16 * d8) = (u32x4){qw[0], qw[1], qw[2], qw[3]};
                       *(LAS u32x4*)(Ks + (32 * c + 4 * tg + i) * PC + 16 * d8) = (u32x4){kw[0], kw[1], kw[2], kw[3]}; }
        }
#pragma unroll
        for (int e = 0; e < 8; ++e) *(LAS u32x2*)(KhT + (8 * d8 + e) * PT + (32 * c + 4 * tg) * 2) = (u32x2){khb[0][e] | (khb[1][e] << 16), khb[2][e] | (khb[3][e] << 16)};
#pragma unroll
        for (int i = 0; i < 4; ++i) { const int idx = tid + NTHREADS * i; *(LAS u32x4*)(VTs + (idx >> 4) * PT + (idx & 15) * 16) = vt[i]; }
    }
    __syncthreads();
#pragma unroll
    for (int cc = 0; cc < 4; ++cc) {
        {
            const int tb = 32 * cc;
            if (OUT) {
                f32x4 s00 = (f32x4){0.f, 0.f, 0.f, 0.f}, s01 = s00, s11 = s00;
#pragma unroll
                for (int kk = 0; kk < 4; ++kk) {
                    const bf16x8 kf0 = *(const LAS bf16x8*)(Ks + (tb + fr) * PC + (32 * kk + 8 * fq) * 2), kf1 = *(const LAS bf16x8*)(Ks + (tb + 16 + fr) * PC + (32 * kk + 8 * fq) * 2);
                    const bf16x8 qf0 = *(const LAS bf16x8*)(Qs + (tb + fr) * PC + (32 * kk + 8 * fq) * 2), qf1 = *(const LAS bf16x8*)(Qs + (tb + 16 + fr) * PC + (32 * kk + 8 * fq) * 2);
                    s00 = __builtin_amdgcn_mfma_f32_16x16x32_bf16(kf0, qf0, s00, 0, 0, 0);
                    s01 = __builtin_amdgcn_mfma_f32_16x16x32_bf16(kf0, qf1, s01, 0, 0, 0);
                    s11 = __builtin_amdgcn_mfma_f32_16x16x32_bf16(kf1, qf1, s11, 0, 0, 0);
                }
#pragma unroll
                for (int e = 0; e < 4; ++e) { const bool keep = (4 * fq + e) <= fr; s00[e] = keep ? s00[e] : 0.f; s11[e] = keep ? s11[e] : 0.f; }
                const bf16x8 pf0 = frag2(pack4(s00), (u32x2){0u, 0u}), pf1 = frag2(pack4(s01), pack4(s11));
                const bf16x8 vf = frag2(*(const LAS u32x2*)(VTs + (16 * wave + fr) * PT + (tb + 4 * fq) * 2), *(const LAS u32x2*)(VTs + (16 * wave + fr) * PT + (tb + 16 + 4 * fq) * 2));
                f32x4 o0 = __builtin_amdgcn_mfma_f32_16x16x32_bf16(vf, pf0, (f32x4){0.f, 0.f, 0.f, 0.f}, 0, 0, 0);
                f32x4 o1 = __builtin_amdgcn_mfma_f32_16x16x32_bf16(vf, pf1, (f32x4){0.f, 0.f, 0.f, 0.f}, 0, 0, 0);
#pragma unroll
                for (int kk = 0; kk < 4; ++kk) {
                    const bf16x8 sf = frag2(pack4(S[2 * kk]), pack4(S[2 * kk + 1]));
                    const bf16x8 q0 = frag2(*(const LAS u32x2*)(Qs + (tb + fr) * PC + (32 * kk + 4 * fq) * 2), *(const LAS u32x2*)(Qs + (tb + fr) * PC + (32 * kk + 16 + 4 * fq) * 2));
                    const bf16x8 q1 = frag2(*(const LAS u32x2*)(Qs + (tb + 16 + fr) * PC + (32 * kk + 4 * fq) * 2), *(const LAS u32x2*)(Qs + (tb + 16 + fr) * PC + (32 * kk + 16 + 4 * fq) * 2));
                    o0 = __builtin_amdgcn_mfma_f32_16x16x32_bf16(sf, q0, o0, 0, 0, 0);
                    o1 = __builtin_amdgcn_mfma_f32_16x16x32_bf16(sf, q1, o1, 0, 0, 0);
                }
                oacc[cc][0] = o0; oacc[cc][1] = o1;
            }
            const bf16x8 vb = *(const LAS bf16x8*)(VTs + (16 * wave + fr) * PT + (tb + 8 * fq) * 2);
#pragma unroll
            for (int dt = 0; dt < 8; ++dt) {
                const f32x4 dc = *(const LAS f32x4*)(DECs + cc * 128 + 16 * dt + 4 * fq);
                const bf16x8 kf = *(const LAS bf16x8*)(KhT + (16 * dt + fr) * PT + (tb + 8 * fq) * 2);
                S[dt] = __builtin_amdgcn_mfma_f32_16x16x32_bf16(kf, vb, S[dt] * dc, 0, 0, 0);
            }
        }
    }
    if (OUT) {
#pragma unroll
        for (int cc = 0; cc < 4; ++cc)
#pragma unroll
            for (int tt = 0; tt < 2; ++tt) { const f32x4 o = oacc[cc][tt]; float v = (o[0] * o[0] + o[1] * o[1]) + (o[2] * o[2] + o[3] * o[3]);
                v += __shfl_xor(v, 16); v += __shfl_xor(v, 32); if (fq == 0) SSQs[(32 * cc + 16 * tt + fr) * 8 + wave] = v; }
        __syncthreads();
#pragma unroll
        for (int cc = 0; cc < 4; ++cc)
#pragma unroll
            for (int tt = 0; tt < 2; ++tt) { const int t = 32 * cc + 16 * tt + fr;
                const f32x4 a = *(const LAS f32x4*)(SSQs + t * 8), b4 = *(const LAS f32x4*)(SSQs + t * 8 + 4);
                const float r = __builtin_amdgcn_rsqf((((a[0] + a[1]) + (a[2] + a[3])) + ((b4[0] + b4[1]) + (b4[2] + b4[3]))) * (1.0f / 128.0f) + 1e-6f);
                const int col = h * 128 + 16 * wave + 4 * fq;
                const u32x2 g = *(const u32x2*)(GA + (row0 + t) * 512 + col); const f32x4 o = oacc[cc][tt];
                u32x2 w; w.x = pk2(o[0] * r * bflo(g.x), o[1] * r * bfhi(g.x)); w.y = pk2(o[2] * r * bflo(g.y), o[3] * r * bfhi(g.y));
                if (dummy) *(u32x2*)((bf16_t*)(ws + WS_VB) + (row0 + t) * 512 + col) = w; else *(u32x2*)(QAB + (row0 + t) * 1024 + col) = w; }
    } else {
        if (tid < 128) dprod *= (DECs[tid] * DECs[128 + tid]) * (DECs[256 + tid] * DECs[384 + tid]);
    }
    }
    if (!OUT) {
#pragma unroll
        for (int dt = 0; dt < 8; ++dt) *(f32x4*)(stp + 16 * dt) = S[dt];
        if (tid < 128) DEC[(size_t)unit * 128 + tid] = dprod;
    }
}
__device__ __forceinline__ void hgrn_scan(const Params& p, int gtid, int nthr) {
    float* ST = (float*)(p.ws + WS_ST); const float* DEC = (const float*)(p.ws + OFF_DEC);
    for (int i = gtid; i < 16 * 4096; i += nthr) {
        const int bh = i >> 12, q4 = i & 4095, d = (4 * q4) & 127;
        f32x4 run = (f32x4){0.f, 0.f, 0.f, 0.f};
#pragma unroll 8
        for (int j = 0; j < 16; ++j) { f32x4* ps = (f32x4*)(ST + (size_t)(bh * 16 + j) * 16384 + 4 * q4); const f32x4 L = *ps; const f32x4 dc = *(const f32x4*)(DEC + (size_t)(bh * 16 + j) * 128 + d);
            *ps = run; run = dc * run + L; }
    }
}
__device__ __forceinline__ void attn_unit(const Params& p, int unit, LAS unsigned char* lds, int tid, int wave, int lane, bool dummy = false) {
    unsigned char* ws = p.ws;
    bf16_t* QAB = (bf16_t*)(ws + WS_QAB); const bf16_t* KB = (const bf16_t*)(ws + WS_KB); const bf16_t* VBT = (const bf16_t*)(ws + WS_IAT) + (size_t)512 * 128;
    const int bh = unit >> 5, qb = unit & 31, b = bh >> 2, h = bh & 3;
    const size_t row0 = (size_t)b * SEQ;
    constexpr int PC = 272, PT = 144;
    constexpr int ABUF = 64 * PC + 128 * PT;
    LAS unsigned* FL = (LAS unsigned*)(lds + 2 * ABUF);
    const int fr = lane & 15, fq = lane >> 4;
    const int tq = 128 * qb + 16 * wave + fr;
    bf16x8 qf[4];
    { const bf16_t* qp = QAB + (row0 + tq) * 1024 + 512 + h * 128 + 8 * fq;
#pragma unroll
      for (int kk = 0; kk < 4; ++kk) qf[kk] = *(const bf16x8*)(qp + 32 * kk); }
    f32x4 O[8];
#pragma unroll
    for (int dt = 0; dt < 8; ++dt) O[dt] = (f32x4){0.f, 0.f, 0.f, 0.f};
    float R = 0.f; bool wdone = false;
    if (tid < 8) FL[tid] = 0u;
    u32x4 kreg[2], vreg[2];
#define ATT_LOAD(s0_) do { _Pragma("unroll") for (int i = 0; i < 2; ++i) { const int idx = tid + NTHREADS * i; \
        kreg[i] = *(const u32x4*)(KB + (row0 + (s0_) + (idx >> 4)) * 512 + h * 128 + (idx & 15) * 8); \
        vreg[i] = *(const u32x4*)(VBT + (((row0 + (s0_)) >> 7) * 1024 + h * 128 + (idx >> 3)) * 128 + ((s0_) & 127) + (idx & 7) * 8); } } while (0)
#define ATT_STORE(buf_) do { _Pragma("unroll") for (int i = 0; i < 2; ++i) { const int idx = tid + NTHREADS * i; \
        *(LAS u32x4*)(lds + (buf_) * ABUF + (idx >> 4) * PC + (idx & 15) * 16) = kreg[i]; \
        *(LAS u32x4*)(lds + (buf_) * ABUF + 64 * PC + (idx >> 3) * PT + (idx & 7) * 16) = vreg[i]; } } while (0)
    ATT_LOAD(64 * (2 * qb + 1));
    ATT_STORE(0);
    ATT_LOAD(64 * (2 * qb));
    __syncthreads();
    int cur = 0;
    for (int kt0 = 2 * qb + 1; kt0 >= 0; --kt0, cur ^= 1) {
        const int s0 = 64 * kt0;
        { unsigned all = 1u;
#pragma unroll
          for (int i = 0; i < 8; ++i) all &= FL[i];
          if (all) break; }
        if (kt0 > 0) { ATT_STORE(cur ^ 1); if (kt0 > 1) ATT_LOAD(s0 - 128); }
        LAS unsigned char* Ks = lds + cur * ABUF; LAS unsigned char* VTs = Ks + 64 * PC;
        if (s0 < 128 * qb + 16 * wave + 15 && !wdone) {
        f32x4 z[4];
#pragma unroll
        for (int kt = 0; kt < 4; ++kt) { z[kt] = (f32x4){0.f, 0.f, 0.f, 0.f};
#pragma unroll
            for (int kk = 0; kk < 4; ++kk) { const bf16x8 kf = *(const LAS bf16x8*)(Ks + (16 * kt + fr) * PC + (32 * kk + 8 * fq) * 2);
                z[kt] = __builtin_amdgcn_mfma_f32_16x16x32_bf16(kf, qf[kk], z[kt], 0, 0, 0); } }
        f32x4 lk[4]; float T[4];
#pragma unroll
        for (int kt = 0; kt < 4; ++kt) {
#pragma unroll
            for (int e = 0; e < 4; ++e) { const float zz = z[kt][e]; const bool ok = (s0 + 16 * kt + 4 * fq + e) < tq;
                const float v = -(fmaxf(zz, 0.f) + __logf(1.0f + __expf(-fabsf(zz)))); lk[kt][e] = ok ? v : 0.f; }
            T[kt] = (lk[kt][0] + lk[kt][1]) + (lk[kt][2] + lk[kt][3]); }
        float run = R;
        f32x4 P[4];
#pragma unroll
        for (int kt = 3; kt >= 0; --kt) {
            const float t1 = __shfl_xor(T[kt], 16), t2 = __shfl_xor(T[kt], 32), t3 = __shfl_xor(T[kt], 48);
            const float g = (((fq ^ 1) > fq) ? t1 : 0.f) + (((fq ^ 2) > fq) ? t2 : 0.f) + (((fq ^ 3) > fq) ? t3 : 0.f);
            float suf = run + g;
#pragma unroll
            for (int e = 3; e >= 0; --e) { const bool ok = (s0 + 16 * kt + 4 * fq + e) < tq;
                P[kt][e] = ok ? __expf(lk[kt][e] + z[kt][e] + suf) : 0.f; suf += lk[kt][e]; }
            run += (T[kt] + t1) + (t2 + t3);
        }
        R = run;
#pragma unroll
        for (int kp = 0; kp < 2; ++kp) {
            const bf16x8 pf = frag2(pack4(P[2 * kp]), pack4(P[2 * kp + 1]));
#pragma unroll
            for (int dt = 0; dt < 8; ++dt) {
                const int vr = 32 * (dt >> 1) + 8 * (fr >> 2) + 4 * (dt & 1) + (fr & 3);
                const bf16x8 vf = frag2(*(const LAS u32x2*)(VTs + vr * PT + (32 * kp + 4 * fq) * 2), *(const LAS u32x2*)(VTs + vr * PT + (32 * kp + 16 + 4 * fq) * 2));
                O[dt] = __builtin_amdgcn_mfma_f32_16x16x32_bf16(vf, pf, O[dt], 0, 0, 0);
            }
        }
        { const bool done = R < -60.f; const unsigned long long bal = __ballot(done); wdone = (bal == ~0ull); if (lane == 0) FL[wave] = wdone ? 1u : 0u; }
        }
        __syncthreads();
    }
    bf16_t* op = dummy ? (bf16_t*)(ws + WS_VB) + (row0 + tq) * 512 + h * 128 + 8 * fq : QAB + (row0 + tq) * 1024 + 512 + h * 128 + 8 * fq;
#pragma unroll
    for (int k = 0; k < 4; ++k) { const u32x2 lo = pack4(O[2 * k]), hi = pack4(O[2 * k + 1]); *(u32x4*)(op + 32 * k) = (u32x4){lo.x, lo.y, hi.x, hi.y}; }
    __syncthreads();
}

__device__ __forceinline__ void gmix_phase(const Params& p, int o, LAS unsigned char* lds, int vcu, int G, int tid, int wave, int lane) {
    unsigned char* ws = p.ws;
    const bf16_t* VT = (const bf16_t*)(ws + WS_VT); bf16_t* U = (bf16_t*)(ws + WS_U);
    const float* S1 = (const float*)(ws + WS_LNP + (size_t)(2 * o) * LNP_STRIDE); const float* S2 = (const float*)(ws + WS_LNP + (size_t)(2 * o + 1) * LNP_STRIDE);
    const float* lng = p.in[I_LNG] + o * 3072; const float* lnb = p.in[I_LNB] + o * 3072;
    constexpr int PITCH = 272;
    LAS unsigned char* Wp = lds; LAS unsigned char* VTs = lds + 128 * PITCH;
    LAS float* AL = (LAS float*)(lds + 128 * PITCH + 192 * PITCH); LAS float* BE = AL + 128;
    LAS float* MUA = BE + 128; LAS float* RSA = MUA + 512;
    LAS float* LG = RSA + 512; LAS float* LBt = LG + 384;
    const int fr = lane & 15, fq = lane >> 4;
    const int wt = tid >> 2, wsq = tid & 3;
    f32x4 wreg[8];
    u32x4 vreg[6]; u32x4 ureg[6];
#define GM_LOADV(n_, g_, half_) do { _Pragma("unroll") for (int i = 0; i < 6; ++i) { const int idx = tid + NTHREADS * i; \
        vreg[i] = *(const u32x4*)(VT + ((size_t)(n_) * 3072 + (g_) * 384 + (half_) * 192 + (idx >> 4)) * 128 + (idx & 15) * 8); } } while (0)
#define GM_STOREV() do { _Pragma("unroll") for (int i = 0; i < 6; ++i) { const int idx = tid + NTHREADS * i; *(LAS u32x4*)(VTs + (idx >> 4) * PITCH + (idx & 15) * 16) = vreg[i]; } } while (0)
#define GM_LOADU(dst_, n_, g_, half_) do { _Pragma("unroll") for (int kp = 0; kp < 6; ++kp) dst_[kp] = *(const u32x4*)(U + (size_t)((n_) * 128 + 16 * wave + fr) * 3072 + (g_) * 384 + (half_) * 192 + 32 * kp + 8 * fq); } while (0)
    if (vcu < 1024) GM_LOADV(vcu >> 3, vcu & 7, 0);
    __syncthreads();
    {
        const int k = tid >> 7, tk = tid & 127, unit = vcu + k * G;
        if (unit < 1024 && k < 4) { const size_t tok = (size_t)(unit >> 3) * 128 + tk; float a1 = 0.f, a2 = 0.f;
#pragma unroll
            for (int j = 0; j < 6; ++j) { const f32x4 x = *(const f32x4*)(S1 + tok * 24 + 4 * j), y = *(const f32x4*)(S2 + tok * 24 + 4 * j); a1 += (x[0] + x[1]) + (x[2] + x[3]); a2 += (y[0] + y[1]) + (y[2] + y[3]); }
            const float mu = a1 * (1.0f / 3072.0f); const float var = a2 * (1.0f / 3072.0f) - mu * mu; MUA[tid] = mu; RSA[tid] = __builtin_amdgcn_rsqf(fmaxf(var, 0.f) + 1e-6f); }
    }
    int kslot = 0;
    for (int unit = vcu; unit < 1024; unit += G, ++kslot) {
        const int n = unit >> 3, g = unit & 7, T0 = n * 128;
        __syncthreads();
        GM_STOREV();
        GM_LOADU(ureg, n, g, 0);
        { const float* wrow = p.in[I_GMWS] + ((size_t)(o * 8 + g) * 128 + wt) * 128 + 32 * wsq;
#pragma unroll
          for (int j = 0; j < 8; ++j) wreg[j] = *(const f32x4*)(wrow + 4 * j); }
        const LAS float* MU = MUA + 128 * kslot; const LAS float* RS = RSA + 128 * kslot;
        {
            float al = 0.f, be = 0.f;
#pragma unroll
            for (int j = 0; j < 4; ++j) {
                unsigned pk[4];
#pragma unroll
                for (int e2 = 0; e2 < 4; ++e2) {
                    unsigned bits[2];
#pragma unroll
                    for (int hh = 0; hh < 2; ++hh) {
                        const int e = 2 * e2 + hh, s = 32 * wsq + 8 * j + e;
                        float w = wreg[2 * j + (e >> 2)][e & 3]; w = (s <= wt) ? w : 0.f; be += w;
                        bits[hh] = f2bf(w * RS[s]); al += __uint_as_float(bits[hh] << 16) * MU[s];
                    }
                    pk[e2] = bits[0] | (bits[1] << 16);
                }
                *(LAS u32x4*)(Wp + wt * PITCH + (32 * wsq + 8 * j) * 2) = (u32x4){pk[0], pk[1], pk[2], pk[3]};
            }
            al += __shfl_xor(al, 1); al += __shfl_xor(al, 2); be += __shfl_xor(be, 1); be += __shfl_xor(be, 2);
            if (wsq == 0) { AL[wt] = al; BE[wt] = be; }
        }
        GM_LOADV(n, g, 1);
        __syncthreads();
        const int t = 16 * wave + fr; const float al = AL[t], be = BE[t], bsv = p.in[I_GMBS][(o * 8 + g) * 128 + t];
        const int nks = ((16 * wave + 15) >> 5) + 1;
        const float* lngu = lng; const float* lnbu = lnb; asm volatile("" : "+s"(lngu), "+s"(lnbu));
#pragma unroll
        for (int half = 0; half < 2; ++half) {
            const int cg0 = g * 384 + half * 192;
            if (half) { __syncthreads();
                GM_STOREV(); GM_LOADU(ureg, n, g, 1);
                if (unit + G < 1024) GM_LOADV((unit + G) >> 3, (unit + G) & 7, 0);
                __syncthreads(); }
            f32x4 acc[12];
#pragma unroll
            for (int ct = 0; ct < 12; ++ct) acc[ct] = (f32x4){0.f, 0.f, 0.f, 0.f};
            for (int ks = 0; ks < nks; ++ks) {
                const bf16x8 bfrag = *(const LAS bf16x8*)(Wp + (16 * wave + fr) * PITCH + (32 * ks + 8 * fq) * 2);
#pragma unroll
                for (int ct = 0; ct < 12; ++ct) { const bf16x8 afrag = *(const LAS bf16x8*)(VTs + (32 * (ct >> 1) + 8 * (fr >> 2) + 4 * (ct & 1) + (fr & 3)) * PITCH + (32 * ks + 8 * fq) * 2);
                    acc[ct] = __builtin_amdgcn_mfma_f32_16x16x32_bf16(afrag, bfrag, acc[ct], 0, 0, 0); }
            }
#pragma unroll
            for (int kp = 0; kp < 6; ++kp) {
                const int cl = half * 192 + 32 * kp + 8 * fq, cg = g * 384 + cl;
                const f32x4 lg0 = *(const f32x4*)(lngu + cg), lg1 = *(const f32x4*)(lngu + cg + 4), lb0 = *(const f32x4*)(lnbu + cg), lb1 = *(const f32x4*)(lnbu + cg + 4);
                const u32x4 uu = ureg[kp]; const f32x4 a0 = acc[2 * kp], a1 = acc[2 * kp + 1];
                u32x4 w;
                w.x = pk2(bflo(uu.x) * (lg0[0] * (a0[0] - al) + lb0[0] * be + bsv), bfhi(uu.x) * (lg0[1] * (a0[1] - al) + lb0[1] * be + bsv));
                w.y = pk2(bflo(uu.y) * (lg0[2] * (a0[2] - al) + lb0[2] * be + bsv), bfhi(uu.y) * (lg0[3] * (a0[3] - al) + lb0[3] * be + bsv));
                w.z = pk2(bflo(uu.z) * (lg1[0] * (a1[0] - al) + lb1[0] * be + bsv), bfhi(uu.z) * (lg1[1] * (a1[1] - al) + lb1[1] * be + bsv));
                w.w = pk2(bflo(uu.w) * (lg1[2] * (a1[2] - al) + lb1[2] * be + bsv), bfhi(uu.w) * (lg1[3] * (a1[3] - al) + lb1[3] * be + bsv));
                *(u32x4*)(U + (size_t)(T0 + t) * 3072 + cg) = w;
            }
            (void)cg0;
        }
    }
#undef GM_LOADV
#undef GM_STOREV
#undef GM_LOADU
}

constexpr size_t OFF_BAR = 512 * 1024;
#define XB_TMO      128
#define XB_XCNT(j)  (256  + 64 * (j))
#define XB_XSUB(j)  (1280 + 64 * (j))
#define XB_XGEN(j)  (2304 + 64 * (j))
#define XB_TOP      3328
#define XB_TOPGEN   3392
#define XCD_BAR_WORDS 3456
#define XB_SPIN_CAP (1u << 18)

__device__ __forceinline__ unsigned xb_ld(unsigned* p)              { return __hip_atomic_load(p, __ATOMIC_RELAXED, __HIP_MEMORY_SCOPE_AGENT); }
__device__ __forceinline__ unsigned xb_add(unsigned* p, unsigned v) { return __hip_atomic_fetch_add(p, v, __ATOMIC_RELAXED, __HIP_MEMORY_SCOPE_AGENT); }
__device__ __forceinline__ unsigned xb_xcc_id() { return (unsigned)__builtin_amdgcn_s_getreg((3 << 11) | 20) & 0xFu; }
#define XB_SPIN(cond, bar) do { unsigned _sp = 0; while (cond) { __builtin_amdgcn_s_sleep(1); \
    if ((++_sp & 255u) == 0u) { if (xb_ld(&(bar)[XB_TMO])) break; if (_sp > XB_SPIN_CAP) { atomicAdd(&(bar)[XB_TMO], 1u); break; } } } } while (0)

struct XcdBarrier {
    unsigned* bar; unsigned x;
    volatile LAS unsigned* st;
};

__device__ __forceinline__ XcdBarrier xcd_barrier_post(unsigned* bar, volatile LAS unsigned* st) {
    XcdBarrier b; b.bar = bar; b.x = xb_xcc_id(); b.st = st;
    if (threadIdx.x == 0) (void)xb_add(&bar[XB_XCNT(b.x)], 1u);
    return b;
}
__device__ __forceinline__ void xcd_barrier_complete(unsigned* bar, unsigned x, unsigned& nloc, unsigned& nx) {
    const unsigned G = gridDim.x * gridDim.y * gridDim.z;
    unsigned sum, cnt, mine, sp = 0u;
    for (;;) {
        sum = 0u; cnt = 0u; mine = 0u;
#pragma unroll
        for (unsigned j = 0; j < 16; ++j) { const unsigned c = xb_ld(&bar[XB_XCNT(j)]); sum += c; cnt += (c > 0u) ? 1u : 0u; mine = (j == x) ? c : mine; }
        if (sum == G) break;
        __builtin_amdgcn_s_sleep(1);
        if ((++sp & 255u) == 0u) { if (xb_ld(&bar[XB_TMO])) break; if (sp > XB_SPIN_CAP) { atomicAdd(&bar[XB_TMO], 1u); break; } }
    }
    nloc = mine > 0u ? mine : 1u; nx = cnt > 0u ? cnt : 1u;
}

__device__ __forceinline__ void xcd_barrier(const XcdBarrier& b) {
    asm volatile("s_waitcnt vmcnt(0)" ::: "memory");
    __syncthreads();
    if (threadIdx.x == 0) {
        unsigned* bar = b.bar;
        __builtin_amdgcn_s_waitcnt(0);
        unsigned nloc = b.st[0], nx = b.st[1];
        if (nloc == 0u) { xcd_barrier_complete(bar, b.x, nloc, nx); b.st[0] = nloc; b.st[1] = nx; }
        const unsigned old = xb_add(&bar[XB_XSUB(b.x)], 1u);
        const unsigned gen = old / nloc;
        if (old + 1u == (gen + 1u) * nloc) {
            __builtin_amdgcn_fence(__ATOMIC_RELEASE, "agent");
            asm volatile("s_waitcnt vmcnt(0)" ::: "memory");
            const unsigned og = xb_add(&bar[XB_TOP], 1u);
            const unsigned tg = og / nx;
            if (og + 1u == (tg + 1u) * nx) xb_add(&bar[XB_TOPGEN], 1u);
            else XB_SPIN(xb_ld(&bar[XB_TOPGEN]) == tg, bar);
            __builtin_amdgcn_fence(__ATOMIC_ACQUIRE, "agent");
            xb_add(&bar[XB_XGEN(b.x)], 1u);
            asm volatile("s_waitcnt vmcnt(0)" ::: "memory");
        } else {
            XB_SPIN(xb_ld(&bar[XB_XGEN(b.x)]) == gen, bar);
            __builtin_amdgcn_fence(__ATOMIC_ACQUIRE, "agent");
            asm volatile("s_waitcnt vmcnt(0)" ::: "memory");
        }
    }
    __syncthreads();
}

template <class Sched> __device__ __forceinline__ void rstd_table(const Sched& S, const float* ssq, bool cols, LAS float* tab, int tid) {
    pg8::Unit u;
    for (int i = 0; S.next(i, u); ++i) {
        const int base = (cols ? u.pn : u.pm) * 256;
#pragma unroll
        for (int k = 0; k < 2; ++k) { const int idx = tid + NTHREADS * k, r = idx >> 2, qd = idx & 3;
            const f32x4 v = *(const f32x4*)(ssq + (size_t)(base + r) * 16 + 4 * qd); float t = (v[0] + v[1]) + (v[2] + v[3]);
            t += __shfl_xor(t, 1); t += __shfl_xor(t, 2);
            if (qd == 0) tab[i * 256 + r] = __builtin_amdgcn_rsqf(t * (1.0f / 1024.0f) + 1e-6f); }
    }
    __syncthreads();
}
#ifndef PROBE
#define PROBE 0
#endif
#define REP(mask) for (int rep_ = ((PROBE) & (mask)) ? 0 : 1; rep_ < 2; ++rep_)
__global__ void __launch_bounds__(NTHREADS, 2) fwd(Params p) {
    extern __shared__ __attribute__((aligned(16))) unsigned char lds_raw[];
    LAS unsigned char* lds = (LAS unsigned char*)lds_raw;
    cg::grid_group grid = cg::this_grid();
    int tid = threadIdx.x, lane = tid & 63;
    const int wave = __builtin_amdgcn_readfirstlane(tid >> 6);
    const int G = gridDim.x, bx = blockIdx.x;
    const int vcu = (G % 8 == 0) ? (bx % 8) * (G / 8) + bx / 8 : bx;
    const int gw = vcu * NWAVES + wave, ngw = G * NWAVES;
    Params q = p;
    LAS float* RST = (LAS float*)(lds + 131072);
    volatile LAS unsigned* bst = (volatile LAS unsigned*)(lds + LDS_BYTES - 64);
    if (tid < 2) bst[tid] = 0u;
    __syncthreads();
    XcdBarrier xbar = xcd_barrier_post((unsigned*)(p.ws + OFF_BAR), bst);
    int ph = 0;
#define PHASE_BEGIN() (ph >= p.ph_lo && ph < p.ph_hi)
#define PHASE_END() do { if (ph >= p.ph_lo && ph + 1 < p.ph_hi) { REP(32) { xcd_barrier(xbar); } } ++ph; } while (0)
#define LAUNDER() asm volatile("" : "+s"(q.out), "+s"(q.ws), "+v"(tid), "+v"(lane)); \
    unsigned char* ws = q.ws; float* SSQ = (float*)(ws + WS_SSQ); bf16_t* XB = (bf16_t*)(ws + WS_XB); (void)SSQ; (void)XB

    if (PHASE_BEGIN()) {
        LAUNDER();
        if (bx == 0) { float* LB = (float*)(ws + OFF_LB); const float* lg = q.in[I_LBL];
            const float l0 = lg[tid], l1 = lg[512 + tid], mx = fmaxf(l0, l1), e0 = __expf(l0 - mx), e1 = __expf(l1 - mx), inv = 1.0f / (e0 + e1);
            const float c0 = e0 * inv, c1 = c0 + e1 * inv; LB[tid] = c0 - c0; LB[512 + tid] = c1 - c0; }
        for (int row = gw; row < M; row += ngw) {
            const f32x4* xr = (const f32x4*)(q.in[I_X] + (size_t)row * D) + lane; f32x4 v[4]; float s = 0.f;
#pragma unroll
            for (int j = 0; j < 4; ++j) { v[j] = xr[64 * j]; s += (v[j][0] * v[j][0] + v[j][1] * v[j][1]) + (v[j][2] * v[j][2] + v[j][3] * v[j][3]); }
            s = wave_sum(s); if (lane < 4) *(f32x4*)(SSQ + (size_t)row * 16 + 4 * lane) = (f32x4){lane == 0 ? s : 0.f, 0.f, 0.f, 0.f};
            u32x2* o8 = (u32x2*)(XB + (size_t)row * D) + lane;
#pragma unroll
            for (int j = 0; j < 4; ++j) { u32x2 w; w.x = pk2(v[j][0], v[j][1]); w.y = pk2(v[j][2], v[j][3]); o8[64 * j] = w; }
        }
        conv_chore(q, 0, 1 | 2 | 4, lds, gw, ngw, wave, lane);
    }
    if (p.ph_lo < 0) grid.sync();
    PHASE_END();

    for (int layer = 0; layer < 4; ++layer) {
        const int e = layer >> 1;
        const bool grpA = ((bx >> 3) & 1) == 0;
        if ((layer & 1) == 0) {
            if (PHASE_BEGIN()) REP(2) {
                { LAUNDER(); const float* ssq_mix = SSQ + (size_t)(2 * layer) * M * 16;
                  pg8::Gemm g{XB, (const bf16_t*)(ws + WS_WA), M, 2560, 1024}; pg8::StaticOrder S; S.init(M, 2560, G, bx);
                  rstd_table(S, ssq_mix, false, RST, tid); pg8::EpiProj E{RST, (const float*)(ws + OFF_LB) + e * 512, q.in[I_HON] + e * 512, (bf16_t*)(ws + WS_QAB), (bf16_t*)(ws + WS_KA), (float*)(ws + WS_LF), (bf16_t*)(ws + WS_GA), (bf16_t*)(ws + WS_KB), 0};
                  pg8::gemm_phase<pg8::EpiProj, pg8::StaticOrder, true, true>(lds, g, S, E); }
                { LAUNDER(); const float* ssq_mix = SSQ + (size_t)(2 * layer) * M * 16;
                  pg8::Gemm g{(const bf16_t*)(ws + WS_WB), XB, 1024, M, 1024}; pg8::StaticOrder S; S.init(1024, M, G, bx);
                  rstd_table(S, ssq_mix, true, RST, tid); pg8::EpiT<0> E{RST, (bf16_t*)(ws + WS_IAT), 1024, nullptr, nullptr};
                  pg8::gemm_phase<pg8::EpiT<0>, pg8::StaticOrder, true, true>(lds, g, S, E); }
            }
            PHASE_END();
            if (PHASE_BEGIN()) { REP(4) { LAUNDER(); for (int u = vcu; u < 256; u += G) hgrn_unit<false>(q, u, lds, tid, wave, lane); } REP(8) { LAUNDER(); for (int u = vcu; u < 512; u += G) attn_unit(q, (u & ~31) | (31 - (u & 31)), lds, tid, wave, lane, rep_ == 0); } }
            PHASE_END();
            if (PHASE_BEGIN()) { LAUNDER(); hgrn_scan(q, vcu * NTHREADS + tid, G * NTHREADS); }
            PHASE_END();
            if (PHASE_BEGIN()) REP(16) { LAUNDER(); for (int u = vcu; u < 256; u += G) hgrn_unit<true>(q, u, lds, tid, wave, lane, rep_ == 0); }
            PHASE_END();
        } else {
            if (PHASE_BEGIN()) REP(2) {
                { LAUNDER(); const float* ssq_mix = SSQ + (size_t)(2 * layer) * M * 16;
                  pg8::Gemm g{XB, (const bf16_t*)(ws + WS_WA), M, 3072, 1024}; pg8::StaticOrder S; S.init(M, 3072, G, bx);
                  rstd_table(S, ssq_mix, false, RST, tid); pg8::EpiRow<1> E{RST, (bf16_t*)(ws + WS_U), 3072};
                  pg8::gemm_phase<pg8::EpiRow<1>, pg8::StaticOrder, true, true>(lds, g, S, E); }
                { LAUNDER(); const float* ssq_mix = SSQ + (size_t)(2 * layer) * M * 16;
                  pg8::Gemm g{(const bf16_t*)(ws + WS_WB), XB, 3072, M, 1024}; pg8::StaticOrder S; S.init(3072, M, G, bx);
                  rstd_table(S, ssq_mix, true, RST, tid); pg8::EpiT<1> E{RST, (bf16_t*)(ws + WS_VT), 3072, (float*)(ws + WS_LNP + (size_t)(2 * e) * LNP_STRIDE), (float*)(ws + WS_LNP + (size_t)(2 * e + 1) * LNP_STRIDE)};
                  pg8::gemm_phase<pg8::EpiT<1>, pg8::StaticOrder, true, true>(lds, g, S, E); }
            }
            PHASE_END();
            if (PHASE_BEGIN()) { LAUNDER(); gmix_phase(q, e, lds, vcu, G, tid, wave, lane); }
            PHASE_END();
        }
        for (int r = 0; r < 2; ++r) {
            if (r == 1) {
                if (PHASE_BEGIN()) { LAUNDER();
                    if (grpA) { conv_chore(q, layer + 1, 2, lds, gw, ngw, wave, lane); __syncthreads(); }
                    { pg8::Gemm g{XB, (const bf16_t*)(ws + WS_W1), M, 4096, 1024}; pg8::StaticOrder S; S.init(M, 4096, G, bx);
                    rstd_table(S, SSQ + (size_t)(2 * layer + 1) * M * 16, false, RST, tid); pg8::EpiRow<2> E{RST, (bf16_t*)(ws + WS_H), 4096};
                    pg8::gemm_phase<pg8::EpiRow<2>, pg8::StaticOrder, true, true>(lds, g, S, E); }
                    if (!grpA) { __syncthreads(); conv_chore(q, layer + 1, 2, lds, gw, ngw, wave, lane); } }
                PHASE_END();
            }
            if (PHASE_BEGIN()) {
                LAUNDER(); const int rep_ = 1;
                if (grpA) { if (r == 0) { conv_chore(q, layer, 8, lds, gw, ngw, wave, lane); conv_chore(q, layer + 1, 1, lds, gw, ngw, wave, lane); } else conv_chore(q, layer + 1, 4, lds, gw, ngw, wave, lane); __syncthreads(); }
                const bf16_t* A = r ? (const bf16_t*)(ws + WS_H) : (const bf16_t*)(ws + WS_ACT);
                const int K = r ? 4096 : ((layer & 1) ? 3072 : 1024);
                pg8::Gemm g{A, (const bf16_t*)(ws + (r ? WS_W2 : WS_WO)), M, 1024, K}; pg8::StaticOrder S; S.init(M, 1024, G, bx);
                pg8::EpiRes E{XB, SSQ + (size_t)(2 * layer + 1 + r) * M * 16};
                pg8::gemm_phase<pg8::EpiRes, pg8::StaticOrder, true, true>(lds, g, S, E);
                if (!grpA) { __syncthreads(); if (r == 0) { conv_chore(q, layer, 8, lds, gw, ngw, wave, lane); conv_chore(q, layer + 1, 1, lds, gw, ngw, wave, lane); } else conv_chore(q, layer + 1, 4, lds, gw, ngw, wave, lane); }
            }
            PHASE_END();
        }
    }
    if (PHASE_BEGIN()) {
        LAUNDER();
        const float* fn = q.in[I_FN]; const float* sq = SSQ + (size_t)8 * M * 16;
        for (int row = gw; row < M; row += ngw) {
            const float r = pg8::rstd1024(sq + (size_t)row * 16);
            f32x4* xr = (f32x4*)(q.out + (size_t)row * D) + lane; const u32x2* xb = (const u32x2*)(XB + (size_t)row * D) + lane;
#pragma unroll
            for (int j = 0; j < 4; ++j) { const f32x4 gn = *((const f32x4*)fn + lane + 64 * j); const u32x2 w = xb[64 * j];
                xr[64 * j] = (f32x4){bflo(w.x), bfhi(w.x), bflo(w.y), bfhi(w.y)} * r * gn; }
        }
    }
}
constexpr int N_PHASES = 1 + 3 + 2 * (4 + 3) + 2 * (3 + 3) + 1;

extern "C" void kernel_launch(void* const* d_in, const int* in_sizes, int n_in, void* d_out, int out_size, void* d_ws, size_t ws_size, hipStream_t stream) {
    static int grid = 0;
    if (grid == 0) {
        if (n_in != 16 || out_size != M * D || ws_size < WS_END) { fprintf(stderr, "kernel_launch: unexpected shapes: n_in %d out %d ws %zu (need %zu)\n", n_in, out_size, ws_size, (size_t)WS_END); grid = -1; return; }
        int dev = 0, cus = 0, per_cu = 0;
        hipGetDevice(&dev); hipDeviceGetAttribute(&cus, hipDeviceAttributeMultiprocessorCount, dev);
        hipFuncSetAttribute((const void*)fwd, hipFuncAttributeMaxDynamicSharedMemorySize, LDS_BYTES);
        hipOccupancyMaxActiveBlocksPerMultiprocessor(&per_cu, (const void*)fwd, NTHREADS, LDS_BYTES);
        (void)hipGetLastError();
        if (per_cu < 1) per_cu = 1;
        grid = cus * per_cu;
        if (grid < 256 || (grid & 7)) { fprintf(stderr, "kernel_launch: grid %d unsupported (needs a multiple of 8, >= 256)\n", grid); grid = -1; return; }
        fprintf(stderr, "kernel_launch: grid %d (cus %d x %d)\n", grid, cus, per_cu);
    }
    if (grid < 0) return;
    Params p{};
    for (int i = 0; i < 16; ++i) p.in[i] = (const float*)d_in[i];
    p.out = (float*)d_out; p.ws = (unsigned char*)d_ws; p.ph_lo = 0; p.ph_hi = 1 << 20;
    if (hipMemsetAsync((char*)d_ws + OFF_BAR, 0, 16384, stream) != hipSuccess) fprintf(stderr, "kernel_launch: memset of barrier words failed\n");
    void* args[] = {&p};
    hipError_t err = hipLaunchCooperativeKernel((const void*)fwd, dim3(grid), dim3(NTHREADS), args, LDS_BYTES, stream);
    if (err != hipSuccess) fprintf(stderr, "kernel_launch: cooperative launch failed: %s (grid %d)\n", hipGetErrorString(err), grid);
}
```

```cpp
#ifndef PROBE
#define PROBE 0
#endif
#include <hip/hip_runtime.h>
#include <hip/hip_cooperative_groups.h>
#include <cstdio>
#include <cstdint>
namespace cg = cooperative_groups;
namespace pg8 {
#define PG8_LAS __attribute__((address_space(3)))
typedef unsigned short bf16_t;
typedef short bf16x8 __attribute__((ext_vector_type(8)));
typedef float f32x4 __attribute__((ext_vector_type(4)));
typedef unsigned u32x4 __attribute__((ext_vector_type(4)));
constexpr int BM = 256, BK = 64, HALF = 128, HTB = HALF * BK * 2  , STAGE_BYTES = 8 * HTB, NXCD = 8, WGM = 8;

__host__ __device__ __forceinline__ int lds_byte(int r, int c) { const int st = (r >> 4) * 2 + (c >> 5), rr = r & 15, cc = c & 31, ob = rr * 64 + cc * 2; return st * 1024 + (ob ^ (((ob >> 9) & 1) << 5)); }
__host__ __device__ __forceinline__ void stage_rc(int b, int& R, int& C) { const int st = b / 1024, sb = b % 1024, swz = sb ^ (((sb >> 9) & 1) << 5); R = (st >> 1) * 16 + swz / 64; C = (st & 1) * 32 + (swz % 64) / 2; }
__host__ __device__ __forceinline__ int perm32(int rho) { const int n = rho >> 4, i = rho & 15; return 8 * (i >> 2) + 4 * n + (i & 3); }

struct Unit { int pm, pn, ord; };
struct Gemm { const bf16_t* A; const bf16_t* Bt; int M, N, K; };

struct StaticOrder {
    int nM, nN, nwg, G, c;
    __host__ __device__ void init(int M, int N, int G_, int c_) { nM = M / BM; nN = N / BM; nwg = nM * nN; G = G_; c = c_; }
    __host__ __device__ bool next(int i, Unit& u) const {
        const long L = (long)i * G + c; if (L >= nwg) return false;
        int wgid = (int)L; { const int q = nwg / NXCD, r = nwg % NXCD, xcd = wgid % NXCD, off = wgid / NXCD; wgid = (xcd < r ? xcd * (q + 1) : r * (q + 1) + (xcd - r) * q) + off; }
        const int nig = WGM * nN, gid = wgid / nig, fm = gid * WGM, gsz = (nM - fm) < WGM ? (nM - fm) : WGM;
        u.pm = fm + ((wgid % nig) % gsz); u.pn = (wgid % nig) / gsz; u.ord = i; return true;
    }
    __device__ __forceinline__ void a_ready(const Unit&) const {}
    __device__ __forceinline__ void done(const Unit&) const {}
};

__device__ __forceinline__ unsigned cvt_pk_bf16(float lo, float hi) { unsigned r; asm volatile("v_cvt_pk_bf16_f32 %0, %1, %2" : "=v"(r) : "v"(lo), "v"(hi)); return r; }
typedef float f32x2 __attribute__((ext_vector_type(2)));
__device__ __forceinline__ f32x2 gelu_pk(f32x2 v) {
    const f32x2 av = __builtin_elementwise_abs(v), d = av * 0.2316418882f + 1.0f;
    f32x2 t; t.x = __builtin_amdgcn_rcpf(d.x); t.y = __builtin_amdgcn_rcpf(d.y);
    f32x2 q = t * 0.5307027145f + (-0.7265760135f); q = q * t + 0.7107068705f; q = q * t + (-0.142248368f); q = q * t + 0.127414796f; q = q * t;
    const f32x2 s = (v * v) * (-0.72134752044f);
    f32x2 e; e.x = __builtin_amdgcn_exp2f(s.x); e.y = __builtin_amdgcn_exp2f(s.y);
    const f32x2 m = v * (q * e), r = v - m;
    f32x2 o; o.x = v.x < 0.f ? m.x : r.x; o.y = v.y < 0.f ? m.y : r.y; return o;
}
typedef unsigned u32x2 __attribute__((ext_vector_type(2)));
__device__ __forceinline__ float rstd1024(const float* s16) { const f32x4 a = *(const f32x4*)s16, b = *(const f32x4*)(s16 + 4), c = *(const f32x4*)(s16 + 8), d = *(const f32x4*)(s16 + 12);
    const float t = (((a[0] + a[1]) + (a[2] + a[3])) + ((b[0] + b[1]) + (b[2] + b[3]))) + (((c[0] + c[1]) + (c[2] + c[3])) + ((d[0] + d[1]) + (d[2] + d[3])));
    return __builtin_amdgcn_rsqf(t * (1.0f / 1024.0f) + 1e-6f); }
__device__ __forceinline__ float sigm(float v) { return __builtin_amdgcn_rcpf(1.0f + __expf(-v)); }
__device__ __forceinline__ u32x4 pack8(const f32x4& a, const f32x4& b) { u32x4 w; w.x = cvt_pk_bf16(a[0], a[1]); w.y = cvt_pk_bf16(a[2], a[3]); w.z = cvt_pk_bf16(b[0], b[1]); w.w = cvt_pk_bf16(b[2], b[3]); return w; }

struct EpiProj {
    static constexpr bool PERM = true, AFTER_DRAIN = false, IDEMP = true;
    const PG8_LAS float* rst; const float* lb; const float* gnorm; bf16_t* QAB; bf16_t* KA; float* LF; bf16_t* GA; bf16_t* KB; int seg0;
    __device__ __forceinline__ void operator()(const f32x4 (&acc)[2][2][4][2], const Unit& u, int wr, int wc, int fr, int fq) const {
        asm volatile("" : "+v"(fr), "+v"(fq));
        const int seg = seg0 + (u.pn >> 1);
        const int cb = (u.pn & 1) * 256 + wc * 32 + 8 * fq;
#pragma unroll
        for (int ai = 0; ai < 2; ++ai)
#pragma unroll
            for (int m = 0; m < 4; ++m) {
                const size_t row = (size_t)u.pm * BM + ai * HALF + wr * 64 + m * 16 + fr;
                const float rs = rst[u.ord * 256 + ai * HALF + wr * 64 + m * 16 + fr];
#pragma unroll
                for (int bj = 0; bj < 2; ++bj) {
                    const int c = cb + bj * HALF;
                    f32x4 v0 = acc[ai][bj][m][0] * rs, v1 = acc[ai][bj][m][1] * rs;
                    if (seg == 0) {
#pragma unroll
                        for (int e = 0; e < 4; ++e) { v0[e] = v0[e] * sigm(v0[e]); v1[e] = v1[e] * sigm(v1[e]); }
                        *(u32x4*)(QAB + row * 1024 + c) = pack8(v0, v1);
                    } else if (seg == 1) {
                        const f32x4 l0 = *(const f32x4*)(lb + c), l1 = *(const f32x4*)(lb + c + 4);
                        f32x4 lf0, lf1, k0, k1;
#pragma unroll
                        for (int e = 0; e < 4; ++e) {
                            const float s0 = sigm(v0[e]), s1 = sigm(v1[e]);
                            lf0[e] = __logf(l0[e] + (1.0f - l0[e]) * s0); lf1[e] = __logf(l1[e] + (1.0f - l1[e]) * s1);
                            k0[e] = (1.0f - l0[e]) * sigm(-v0[e]); k1[e] = (1.0f - l1[e]) * sigm(-v1[e]);
                        }
                        *(f32x4*)(LF + row * 512 + c) = lf0; *(f32x4*)(LF + row * 512 + c + 4) = lf1;
                        *(u32x4*)(KA + row * 512 + c) = pack8(k0, k1);
                    } else if (seg == 4) {
                        const f32x4 g0 = *(const f32x4*)(gnorm + c), g1 = *(const f32x4*)(gnorm + c + 4);
#pragma unroll
                        for (int e = 0; e < 4; ++e) { v0[e] = g0[e] * v0[e] * sigm(v0[e]); v1[e] = g1[e] * v1[e] * sigm(v1[e]); }
                        *(u32x4*)(GA + row * 512 + c) = pack8(v0, v1);
                    } else if (seg == 2) {
                        v0 = v0 * 0.08838834764831845f; v1 = v1 * 0.08838834764831845f;
                        *(u32x4*)(QAB + row * 1024 + 512 + c) = pack8(v0, v1);
                    } else {
                        *(u32x4*)(KB + row * 512 + c) = pack8(v0, v1);
                    }
                }
                asm volatile("" ::: "memory");
            }
    }
};

template <int ACT> struct EpiRow {
    static constexpr bool PERM = true, AFTER_DRAIN = false, IDEMP = true;
    const PG8_LAS float* rst; bf16_t* O; int ldc;
    __device__ __forceinline__ void operator()(const f32x4 (&acc)[2][2][4][2], const Unit& u, int wr, int wc, int fr, int fq) const {
        asm volatile("" : "+v"(fr), "+v"(fq));
        bf16_t* base = O + (size_t)u.pm * BM * ldc + u.pn * BM; const PG8_LAS float* sb = rst + u.ord * 256;
        const unsigned r0 = wr * 64 + fr, c0 = wc * 32 + 8 * fq;
#pragma unroll
        for (int ai = 0; ai < 2; ++ai)
#pragma unroll
            for (int m = 0; m < 4; ++m) {
                const unsigned row = r0 + ai * HALF + m * 16;
                const float rs = sb[row];
#pragma unroll
                for (int bj = 0; bj < 2; ++bj) {
                    f32x4 v0 = acc[ai][bj][m][0] * rs, v1 = acc[ai][bj][m][1] * rs;
                    if (ACT == 1) { f32x2 a = gelu_pk((f32x2){v0[0], v0[1]}), b = gelu_pk((f32x2){v0[2], v0[3]}), c = gelu_pk((f32x2){v1[0], v1[1]}), d = gelu_pk((f32x2){v1[2], v1[3]});
                        v0 = (f32x4){a.x, a.y, b.x, b.y}; v1 = (f32x4){c.x, c.y, d.x, d.y}; }
                    else {
#pragma unroll
                        for (int e = 0; e < 4; ++e) { const float a = fmaxf(v0[e], 0.f), b = fmaxf(v1[e], 0.f); v0[e] = a * a; v1[e] = b * b; } }
                    *(u32x4*)(base + row * (unsigned)ldc + c0 + bj * HALF) = pack8(v0, v1);
                }
                asm volatile("" ::: "memory");
            }
    }
};

template <int ACT> struct EpiT {
    static constexpr bool PERM = true, AFTER_DRAIN = false, IDEMP = true;
    const PG8_LAS float* rst; bf16_t* O; int nch; float* s1; float* s2;
    __device__ __forceinline__ void operator()(const f32x4 (&acc)[2][2][4][2], const Unit& u, int wr, int wc, int fr, int fq) const {
        asm volatile("" : "+v"(fr), "+v"(fq));
        const int tb = u.pn * BM + wc * 32 + 8 * fq;
        f32x4 rs[2][2];
#pragma unroll
        for (int bj = 0; bj < 2; ++bj)
#pragma unroll
            for (int n = 0; n < 2; ++n) rs[bj][n] = *(const PG8_LAS f32x4*)(rst + u.ord * 256 + wc * 32 + 8 * fq + bj * HALF + 4 * n);
        bf16_t* ob = O + ((size_t)(u.pn * 2) * nch + u.pm * BM) * 128 + wc * 32 + 8 * fq;
        f32x4 a1[2][2], a2[2][2];
#pragma unroll
        for (int bj = 0; bj < 2; ++bj)
#pragma unroll
            for (int n = 0; n < 2; ++n) { a1[bj][n] = (f32x4){0.f, 0.f, 0.f, 0.f}; a2[bj][n] = (f32x4){0.f, 0.f, 0.f, 0.f}; }
#pragma unroll
        for (int ai = 0; ai < 2; ++ai)
#pragma unroll
            for (int m = 0; m < 4; ++m) {
                const unsigned row = ai * HALF + wr * 64 + m * 16 + fr;
#pragma unroll
                for (int bj = 0; bj < 2; ++bj) {
                    f32x4 v0 = acc[ai][bj][m][0] * rs[bj][0], v1 = acc[ai][bj][m][1] * rs[bj][1];
                    if (ACT == 1) { f32x2 a = gelu_pk((f32x2){v0[0], v0[1]}), b = gelu_pk((f32x2){v0[2], v0[3]}), c = gelu_pk((f32x2){v1[0], v1[1]}), d = gelu_pk((f32x2){v1[2], v1[3]});
                        v0 = (f32x4){a.x, a.y, b.x, b.y}; v1 = (f32x4){c.x, c.y, d.x, d.y};
                        a1[bj][0] += v0; a1[bj][1] += v1; a2[bj][0] += v0 * v0; a2[bj][1] += v1 * v1; }
                    *(u32x4*)(ob + ((unsigned)bj * (unsigned)nch + row) * 128u) = pack8(v0, v1);
                }
                asm volatile("" ::: "memory");
            }
        if (ACT == 1) {
#pragma unroll
            for (int bj = 0; bj < 2; ++bj)
#pragma unroll
                for (int n = 0; n < 2; ++n)
#pragma unroll
                    for (int e = 0; e < 4; ++e) {
                        float x = a1[bj][n][e], y = a2[bj][n][e];
#pragma unroll
                        for (int o = 1; o < 16; o <<= 1) { x += __shfl_xor(x, o); y += __shfl_xor(y, o); }
                        if (fr == 0) { const size_t sl = (size_t)(tb + bj * HALF + 4 * n + e) * 24 + u.pm * 2 + wr; s1[sl] = x; s2[sl] = y; }
                    }
        }
    }
};

struct EpiRes {
    static constexpr bool PERM = true, AFTER_DRAIN = false, IDEMP = false;
    bf16_t* XB; float* ssq_next;
    __device__ __forceinline__ void operator()(const f32x4 (&acc)[2][2][4][2], const Unit& u, int wr, int wc, int fr, int fq) const {
        asm volatile("" : "+v"(fr), "+v"(fq));
        const int cb = u.pn * BM + wc * 32 + 8 * fq;
#pragma unroll
        for (int ai = 0; ai < 2; ++ai)
#pragma unroll
            for (int m = 0; m < 4; ++m) {
                const size_t row = (size_t)u.pm * BM + ai * HALF + wr * 64 + m * 16 + fr;
                float part = 0.f;
#pragma unroll
                for (int bj = 0; bj < 2; ++bj) {
                    const size_t off = row * 1024 + cb + bj * HALF;
                    const u32x4 xo = *(const u32x4*)(XB + off);
                    f32x4 x0, x1;
                    x0[0] = __uint_as_float(xo.x << 16); x0[1] = __uint_as_float(xo.x & 0xffff0000u); x0[2] = __uint_as_float(xo.y << 16); x0[3] = __uint_as_float(xo.y & 0xffff0000u);
                    x1[0] = __uint_as_float(xo.z << 16); x1[1] = __uint_as_float(xo.z & 0xffff0000u); x1[2] = __uint_as_float(xo.w << 16); x1[3] = __uint_as_float(xo.w & 0xffff0000u);
                    x0 += acc[ai][bj][m][0]; x1 += acc[ai][bj][m][1];
                    const u32x4 w = pack8(x0, x1);
                    *(u32x4*)(XB + off) = w;
                    x0[0] = __uint_as_float(w.x << 16); x0[1] = __uint_as_float(w.x & 0xffff0000u); x0[2] = __uint_as_float(w.y << 16); x0[3] = __uint_as_float(w.y & 0xffff0000u);
                    x1[0] = __uint_as_float(w.z << 16); x1[1] = __uint_as_float(w.z & 0xffff0000u); x1[2] = __uint_as_float(w.w << 16); x1[3] = __uint_as_float(w.w & 0xffff0000u);
                    part += ((x0[0] * x0[0] + x0[1] * x0[1]) + (x0[2] * x0[2] + x0[3] * x0[3])) + ((x1[0] * x1[0] + x1[1] * x1[1]) + (x1[2] * x1[2] + x1[3] * x1[3]));
                }
                part += __shfl_xor(part, 16); part += __shfl_xor(part, 32);
                if (fq == 0) ssq_next[row * 16 + u.pn * 4 + wc] = part;
            }
    }
};

template <class Epi, class Sched, bool ALIGN_EPI = false, bool SP2 = false>
__device__ __forceinline__ void gemm_phase(PG8_LAS unsigned char* lds, const Gemm g, const Sched& S, const Epi& E) {
    int tid_ = threadIdx.x; asm volatile("" : "+v"(tid_), "+s"(lds));
    const int tid = tid_, wid = __builtin_amdgcn_readfirstlane(tid >> 6), lane = tid & 63, wr = wid >> 2, wc = wid & 3, fr = lane & 15, fq = lane >> 4;
    const bf16_t* gA = g.A; const bf16_t* gBt = g.Bt; asm volatile("" : "+s"(gA), "+s"(gBt));
    const int K = g.K, nt = K / BK;
    unsigned voffA[2], voffB[2];
#pragma unroll
    for (int i = 0; i < 2; ++i) { int R, C; stage_rc(tid * 16 + i * 8192, R, C); const int Rb = Epi::PERM ? ((R & ~31) + perm32(R & 31)) : R;
        voffA[i] = (unsigned)(R * K + C) * 2u; voffB[i] = (unsigned)(Rb * K + C) * 2u; }
    const size_t kstep = (size_t)(BK * 2);
    const size_t hstep = (size_t)HALF * K * 2;
    const size_t tstep = 2 * hstep;
    const unsigned ldsw = (unsigned)wid * 1024u;
    const int aoff = lds_byte(wr * 64 + fr, fq * 8), boff = lds_byte(wc * 32 + fr, fq * 8);
#define PG8_SA(b, h) (((b) * 2 + (h)) * HTB)
#define PG8_SB(b, h) ((4 + (b) * 2 + (h)) * HTB)
#define PG8_STAGE(bufoff, gbase, voff) do { _Pragma("unroll") for (int _i = 0; _i < 2; ++_i) \
        __builtin_amdgcn_global_load_lds((const unsigned*)((const char*)(gbase) + (voff)[_i]), (PG8_LAS unsigned*)(lds + (bufoff) + ldsw + _i * 8192), 16, 0, 0); } while (0)
#define PG8_LDA(dst, b, h) do { _Pragma("unroll") for (int m = 0; m < 4; ++m) _Pragma("unroll") for (int k = 0; k < 2; ++k) dst[m][k] = *(const PG8_LAS bf16x8*)(lds + PG8_SA(b, h) + aoff + m * 2048 + k * 1024); } while (0)
#define PG8_LDB(dst, b, h) do { _Pragma("unroll") for (int n = 0; n < 2; ++n) _Pragma("unroll") for (int k = 0; k < 2; ++k) dst[n][k] = *(const PG8_LAS bf16x8*)(lds + PG8_SB(b, h) + boff + n * 2048 + k * 1024); } while (0)
#define PG8_MMA(ai, bj, At, Bt) do { __builtin_amdgcn_s_setprio(1); _Pragma("unroll") for (int m = 0; m < 4; ++m) _Pragma("unroll") for (int n = 0; n < 2; ++n) _Pragma("unroll") for (int k = 0; k < 2; ++k) \
        acc[ai][bj][m][n] = __builtin_amdgcn_mfma_f32_16x16x32_bf16(Bt[n][k], At[m][k], acc[ai][bj][m][n], 0, 0, 0); __builtin_amdgcn_s_setprio(0); } while (0)
#define PG8_WAIT_V(n) asm volatile("s_waitcnt vmcnt(" #n ")" ::: "memory")
#define PG8_WAIT_L(n) asm volatile("s_waitcnt lgkmcnt(" #n ")" ::: "memory")
#define PG8_BAR __builtin_amdgcn_s_barrier()
#define PG8_SCHED __builtin_amdgcn_sched_barrier(0)
    Unit cur, nxt; int ui = 0;
    if (!S.next(0, cur)) return;
    f32x4 acc[2][2][4][2];
#pragma unroll
    for (int a = 0; a < 2; ++a)
#pragma unroll
        for (int b = 0; b < 2; ++b)
#pragma unroll
            for (int m = 0; m < 4; ++m)
#pragma unroll
                for (int n = 0; n < 2; ++n) acc[a][b][m][n] = (f32x4){0.f, 0.f, 0.f, 0.f};
    bf16x8 At[4][2], B0[2][2], B1[2][2];
    const char* cA = (const char*)gA + (size_t)cur.pm * tstep; const char* cB = (const char*)gBt + (size_t)cur.pn * tstep;
    S.a_ready(cur);
    if constexpr (SP2) {
        PG8_STAGE(PG8_SB(0, 0), cB, voffB); PG8_STAGE(PG8_SB(0, 1), cB + hstep, voffB); PG8_STAGE(PG8_SA(0, 0), cA, voffA); PG8_STAGE(PG8_SA(0, 1), cA + hstep, voffA);
        if (wr == 1) PG8_BAR;
        PG8_WAIT_V(2); PG8_BAR;
        PG8_STAGE(PG8_SB(1, 0), cB + kstep, voffB); PG8_STAGE(PG8_SA(1, 0), cA + kstep, voffA); PG8_STAGE(PG8_SB(1, 1), cB + hstep + kstep, voffB);
        PG8_WAIT_V(6); PG8_BAR;
    } else {
        PG8_STAGE(PG8_SB(0, 0), cB, voffB); PG8_STAGE(PG8_SA(0, 0), cA, voffA); PG8_STAGE(PG8_SB(0, 1), cB + hstep, voffB); PG8_STAGE(PG8_SA(0, 1), cA + hstep, voffA);
        if (wr == 1) PG8_BAR;
        PG8_WAIT_V(4); PG8_BAR;
        PG8_STAGE(PG8_SB(1, 0), cB + kstep, voffB); PG8_STAGE(PG8_SA(1, 0), cA + kstep, voffA); PG8_STAGE(PG8_SB(1, 1), cB + hstep + kstep, voffB);
        PG8_WAIT_V(6); PG8_BAR;
    }
    for (;;) {
        const bool has_next = S.next(ui + 1, nxt);
        const char* nA = has_next ? (const char*)gA + (size_t)nxt.pm * tstep : cA; const char* nB = has_next ? (const char*)gBt + (size_t)nxt.pn * tstep : cB;
        for (int t = 0; t < nt; t += 2) {
            const bool last = (t == nt - 2);
            const char* a1 = cA + (size_t)(t + 1) * kstep;
            const char* a2 = last ? nA : cA + (size_t)(t + 2) * kstep; const char* b2 = last ? nB : cB + (size_t)(t + 2) * kstep;
            const char* a3 = a2 + kstep; const char* b3 = b2 + kstep;
            if (last && has_next) S.a_ready(nxt);
            if constexpr (SP2) {
            PG8_LDB(B0, 0, 0); PG8_LDB(B1, 0, 1); PG8_SCHED; PG8_LDA(At, 0, 0); PG8_STAGE(PG8_SA(1, 1), a1 + hstep, voffA);
            PG8_WAIT_V(8); PG8_WAIT_L(0); PG8_BAR; PG8_MMA(0, 0, At, B0); PG8_MMA(0, 1, At, B1); PG8_BAR; PG8_SCHED;
            PG8_LDA(At, 0, 1); PG8_STAGE(PG8_SB(0, 0), b2, voffB); PG8_STAGE(PG8_SB(0, 1), b2 + hstep, voffB); PG8_STAGE(PG8_SA(0, 0), a2, voffA);
            PG8_WAIT_V(8); PG8_WAIT_L(0); PG8_BAR; PG8_MMA(1, 0, At, B0); PG8_MMA(1, 1, At, B1); PG8_BAR; PG8_SCHED;
            PG8_LDB(B0, 1, 0); PG8_LDB(B1, 1, 1); PG8_SCHED; PG8_LDA(At, 1, 0); PG8_STAGE(PG8_SA(0, 1), a2 + hstep, voffA);
            PG8_WAIT_V(8); PG8_WAIT_L(0); PG8_BAR; PG8_MMA(0, 0, At, B0); PG8_MMA(0, 1, At, B1); PG8_BAR; PG8_SCHED;
            PG8_LDA(At, 1, 1); PG8_STAGE(PG8_SB(1, 0), b3, voffB); PG8_STAGE(PG8_SB(1, 1), b3 + hstep, voffB); PG8_STAGE(PG8_SA(1, 0), a3, voffA);
            PG8_WAIT_V(8); PG8_WAIT_L(0); PG8_BAR; PG8_MMA(1, 0, At, B0); PG8_MMA(1, 1, At, B1); PG8_BAR; PG8_SCHED;
            } else {
            PG8_LDB(B0, 0, 0); PG8_SCHED; PG8_LDA(At, 0, 0); PG8_STAGE(PG8_SA(1, 1), a1 + hstep, voffA);
            PG8_WAIT_L(8); PG8_BAR; PG8_WAIT_L(0); PG8_MMA(0, 0, At, B0); PG8_BAR; PG8_SCHED;
            PG8_LDB(B1, 0, 1); PG8_STAGE(PG8_SB(0, 0), b2, voffB);
            PG8_BAR; PG8_WAIT_L(0); PG8_MMA(0, 1, At, B1); PG8_BAR;
            PG8_LDA(At, 0, 1); PG8_STAGE(PG8_SA(0, 0), a2, voffA);
            PG8_BAR; PG8_WAIT_L(0); PG8_MMA(1, 0, At, B0); PG8_BAR; PG8_SCHED;
            PG8_STAGE(PG8_SB(0, 1), b2 + hstep, voffB);
            PG8_WAIT_V(6); PG8_BAR; PG8_MMA(1, 1, At, B1); PG8_BAR;
            PG8_LDB(B0, 1, 0); PG8_SCHED; PG8_LDA(At, 1, 0); PG8_STAGE(PG8_SA(0, 1), a2 + hstep, voffA);
            PG8_WAIT_L(8); PG8_BAR; PG8_WAIT_L(0); PG8_MMA(0, 0, At, B0); PG8_BAR; PG8_SCHED;
            PG8_LDB(B1, 1, 1); PG8_STAGE(PG8_SB(1, 0), b3, voffB);
            PG8_BAR; PG8_WAIT_L(0); PG8_MMA(0, 1, At, B1); PG8_BAR;
            PG8_LDA(At, 1, 1); PG8_STAGE(PG8_SA(1, 0), a3, voffA);
            PG8_BAR; PG8_WAIT_L(0); PG8_MMA(1, 0, At, B0); PG8_BAR; PG8_SCHED;
            PG8_STAGE(PG8_SB(1, 1), b3 + hstep, voffB);
            PG8_WAIT_V(6); PG8_BAR; PG8_MMA(1, 1, At, B1); PG8_BAR;
            }
        }
        if constexpr (ALIGN_EPI) { if (wr == 0) PG8_BAR; }
        if constexpr (!Epi::AFTER_DRAIN) { E(acc, cur, wr, wc, fr, fq);
#if defined(PROBE) && (PROBE & 128)
            if constexpr (Epi::IDEMP) E(acc, cur, wr, wc, fr, fq);
#endif
            S.done(cur); }
        if (!has_next) break;
#pragma unroll
        for (int a = 0; a < 2; ++a)
#pragma unroll
            for (int b = 0; b < 2; ++b)
#pragma unroll
                for (int m = 0; m < 4; ++m)
#pragma unroll
                    for (int n = 0; n < 2; ++n) acc[a][b][m][n] = (f32x4){0.f, 0.f, 0.f, 0.f};
        cur = nxt; cA = nA; cB = nB; ++ui;
        if constexpr (ALIGN_EPI) { if (wr == 1) PG8_BAR; }
    }
    PG8_WAIT_V(0);
    if constexpr (!ALIGN_EPI) { if (wr == 0) PG8_BAR; }
    PG8_BAR;
    if constexpr (Epi::AFTER_DRAIN) { E.fused(acc, cur, wr, wc, fr, fq, lds, wid, lane); S.done(cur); }
#undef PG8_SA
#undef PG8_SB
#undef PG8_STAGE
#undef PG8_LDA
#undef PG8_LDB
#undef PG8_MMA
#undef PG8_WAIT_V
#undef PG8_WAIT_L
#undef PG8_BAR
#undef PG8_SCHED
}
}

#define LAS __attribute__((address_space(3)))
using pg8::bf16_t; using pg8::bf16x8; using pg8::f32x4; using pg8::u32x4; using pg8::u32x2; using pg8::f32x2;
constexpr int M = 16384, D = 1024, SEQ = 4096;
constexpr int NWAVES = 8, NTHREADS = 512;
constexpr int LDS_BYTES = 147456;
constexpr size_t MiB = 1u << 20;
constexpr size_t WS_STAT = 0, OFF_LB = 0;
constexpr size_t WS_WA = 1 * MiB, WS_WB = 7 * MiB, WS_WO = 13 * MiB, WS_W1 = 19 * MiB, WS_W2 = 27 * MiB;
constexpr size_t WS_XB = 35 * MiB;
constexpr size_t WS_ACT = 67 * MiB;
constexpr size_t WS_QAB = WS_ACT, WS_KA = WS_ACT + 32 * MiB, WS_GA = WS_ACT + 48 * MiB, WS_KB = WS_ACT + 64 * MiB, WS_VB = WS_ACT + 80 * MiB, WS_LF = WS_ACT + 96 * MiB, WS_IAT = WS_ACT + 128 * MiB;
constexpr size_t WS_ST = WS_ACT + 160 * MiB;
constexpr size_t WS_H = WS_ACT;
constexpr size_t WS_U = WS_ACT, WS_VT = WS_ACT + 96 * MiB;
constexpr size_t WS_SSQ = WS_VT + 96 * MiB;
constexpr size_t WS_LNP = WS_SSQ + 9 * MiB;
constexpr size_t LNP_STRIDE = (size_t)M * 24 * 4;
constexpr size_t WS_END = WS_LNP + 6 * MiB;

__device__ __forceinline__ unsigned f2bf(float f) { unsigned u = __float_as_uint(f); return (u + 0x7fffu + ((u >> 16) & 1u)) >> 16; }
__device__ __forceinline__ unsigned pk2(float lo, float hi) { return f2bf(lo) | (f2bf(hi) << 16); }
__device__ __forceinline__ float bflo(unsigned u) { return __uint_as_float(u << 16); }
__device__ __forceinline__ float bfhi(unsigned u) { return __uint_as_float(u & 0xffff0000u); }
__device__ __forceinline__ float wave_sum(float v) {
#pragma unroll
    for (int o = 1; o < 64; o <<= 1) v += __shfl_xor(v, o);
    return v;
}

struct Params { const float* in[16]; float* out; unsigned char* ws; int ph_lo, ph_hi; };
enum { I_X = 0, I_MIXN, I_MLPN, I_W1, I_W2, I_ABIN, I_ABOUT, I_LBL, I_HON, I_GMIN, I_LNG, I_LNB, I_GMWS, I_GMBS, I_GMOUT, I_FN };

__device__ __forceinline__ void conv_seg(const float* W, int ldw, int col0, int ncols, int K, const float* gain, bf16_t* WT, int row_off, LAS float* scr, int gw, int ngw, int lane) {
    const int nblk = ncols / 32, nitems = (K / 64) * nblk;
    int it = gw; if (it >= nitems) return;
    const int k8 = lane >> 3, n4 = lane & 7;
    f32x4 cur[8];
    { const int kb = it / nblk, nb = it % nblk; const float* src = W + (size_t)(64 * kb + k8) * ldw + col0 + 32 * nb + 4 * n4;
#pragma unroll
      for (int i = 0; i < 8; ++i) cur[i] = *(const f32x4*)(src + (size_t)(8 * i) * ldw); }
    for (;;) {
        const int nx = it + ngw; const bool has = nx < nitems;
        f32x4 nxt[8];
        if (has) { const int kb = nx / nblk, nb = nx % nblk; const float* src = W + (size_t)(64 * kb + k8) * ldw + col0 + 32 * nb + 4 * n4;
#pragma unroll
            for (int i = 0; i < 8; ++i) nxt[i] = *(const f32x4*)(src + (size_t)(8 * i) * ldw); }
        const int kb = it / nblk, nb = it % nblk, k0 = 64 * kb, n0 = 32 * nb;
#pragma unroll
        for (int i = 0; i < 8; ++i) { LAS float* d = scr + (8 * i + k8) * 33 + 4 * n4; d[0] = cur[i][0]; d[1] = cur[i][1]; d[2] = cur[i][2]; d[3] = cur[i][3]; }
        asm volatile("s_waitcnt lgkmcnt(0)" ::: "memory");
        const int c = lane & 7;
        f32x4 g0 = (f32x4){1.f, 1.f, 1.f, 1.f}, g1 = g0;
        if (gain) { g0 = *(const f32x4*)(gain + k0 + 8 * c); g1 = *(const f32x4*)(gain + k0 + 8 * c + 4); }
#pragma unroll
        for (int j = 0; j < 4; ++j) { const int n = (lane >> 3) + 8 * j; const LAS float* s = scr + (8 * c) * 33 + n;
            u32x4 o; o.x = pk2(s[0 * 33] * g0[0], s[1 * 33] * g0[1]); o.y = pk2(s[2 * 33] * g0[2], s[3 * 33] * g0[3]); o.z = pk2(s[4 * 33] * g1[0], s[5 * 33] * g1[1]); o.w = pk2(s[6 * 33] * g1[2], s[7 * 33] * g1[3]);
            *(u32x4*)(WT + (size_t)(row_off + n0 + n) * K + k0 + 8 * c) = o; }
        asm volatile("s_waitcnt lgkmcnt(0)" ::: "memory");
        if (!has) break;
#pragma unroll
        for (int i = 0; i < 8; ++i) cur[i] = nxt[i];
        it = nx;
    }
}

__device__ __forceinline__ void conv_chore(const Params& p, int layer, int what, LAS unsigned char* lds, int gw, int ngw, int wave, int lane) {
    if (layer > 3) return;
    LAS float* scr = (LAS float*)(lds + wave * 16384);
    unsigned char* ws = p.ws;
    bf16_t* WA = (bf16_t*)(ws + WS_WA); bf16_t* WB = (bf16_t*)(ws + WS_WB); bf16_t* WO = (bf16_t*)(ws + WS_WO); bf16_t* W1 = (bf16_t*)(ws + WS_W1); bf16_t* W2 = (bf16_t*)(ws + WS_W2);
    const float* gmix = p.in[I_MIXN] + layer * 1024; const float* gmlp = p.in[I_MLPN] + layer * 1024;
    const int e = layer >> 1;
    if ((layer & 1) == 0) {
        const float* Win = p.in[I_ABIN] + (size_t)e * 1024 * 3584;
        if (what & 1) {
            const int src[5] = {0, 512, 2048, 2560, 1536};
#pragma unroll
            for (int s = 0; s < 5; ++s) conv_seg(Win, 3584, src[s], 512, 1024, gmix, WA, 512 * s, scr, gw, ngw, lane);
            conv_seg(Win, 3584, 1024, 512, 1024, gmix, WB, 0, scr, gw, ngw, lane);
            conv_seg(Win, 3584, 3072, 512, 1024, gmix, WB, 512, scr, gw, ngw, lane);
        }
        if (what & 2) conv_seg(p.in[I_ABOUT] + (size_t)e * 1024 * 1024, 1024, 0, 1024, 1024, nullptr, WO, 0, scr, gw, ngw, lane);
    } else {
        const float* Win = p.in[I_GMIN] + (size_t)e * 1024 * 6144;
        if (what & 1) { conv_seg(Win, 6144, 0, 3072, 1024, gmix, WA, 0, scr, gw, ngw, lane);
                        conv_seg(Win, 6144, 3072, 3072, 1024, gmix, WB, 0, scr, gw, ngw, lane); }
        if (what & 2) conv_seg(p.in[I_GMOUT] + (size_t)e * 3072 * 1024, 1024, 0, 1024, 3072, nullptr, WO, 0, scr, gw, ngw, lane);
    }
    if (what & 4) conv_seg(p.in[I_W1] + (size_t)layer * 1024 * 4096, 4096, 0, 4096, 1024, gmlp, W1, 0, scr, gw, ngw, lane);
    if (what & 8) conv_seg(p.in[I_W2] + (size_t)layer * 4096 * 1024, 1024, 0, 1024, 4096, nullptr, W2, 0, scr, gw, ngw, lane);
}

__device__ __forceinline__ bf16x8 frag2(const u32x2 lo, const u32x2 hi) { return __builtin_bit_cast(bf16x8, (u32x4){lo.x, lo.y, hi.x, hi.y}); }
__device__ __forceinline__ u32x2 pack4(const f32x4 v) { u32x2 r; r.x = pk2(v[0], v[1]); r.y = pk2(v[2], v[3]); return r; }
constexpr size_t OFF_DEC = 65536;
template <bool OUT>
__device__ __forceinline__ void hgrn_unit(const Params& p, int unit, LAS unsigned char* lds, int tid, int wave, int lane, bool dummy = false) {
    unsigned char* ws = p.ws;
    const float* LF = (const float*)(ws + WS_LF); const bf16_t* KA = (const bf16_t*)(ws + WS_KA); bf16_t* QAB = (bf16_t*)(ws + WS_QAB); const bf16_t* GA = (const bf16_t*)(ws + WS_GA);
    const bf16_t* IAT = (const bf16_t*)(ws + WS_IAT); float* ST = (float*)(ws + WS_ST); float* DEC = (float*)(ws + OFF_DEC);
    const int bh = unit >> 4, jp = unit & 15, b = bh >> 2, h = bh & 3;
    constexpr int PC = 272, PT = 272;
    LAS unsigned char* Qs = lds; LAS unsigned char* Ks = lds + 128 * PC; LAS unsigned char* KhT = lds + 256 * PC; LAS unsigned char* VTs = KhT + 128 * PT;
    LAS float* DECs = (LAS float*)(VTs + 128 * PT); LAS float* SSQs = DECs + 512;
    const int fr = lane & 15, fq = lane >> 4;
    f32x4 S[8];
    float* stp = ST + ((size_t)unit * 128 + 16 * wave + fr) * 128 + 4 * fq;
#pragma unroll
    for (int dt = 0; dt < 8; ++dt) S[dt] = OUT ? *(const f32x4*)(stp + 16 * dt) : (f32x4){0.f, 0.f, 0.f, 0.f};
    float dprod = 1.f;
    for (int sub = 0; sub < 2; ++sub) {
    const size_t row0 = (size_t)b * SEQ + 128 * (2 * jp + sub);
    f32x4 oacc[4][2];
    __syncthreads();
    {
        u32x4 vt[4];
#pragma unroll
        for (int i = 0; i < 4; ++i) { const int idx = tid + NTHREADS * i; vt[i] = *(const u32x4*)(IAT + ((row0 >> 7) * 1024 + h * 128 + (idx >> 4)) * 128 + (idx & 15) * 8); }
        const int tg = tid & 7, d8 = (tid >> 3) & 15, c = tid >> 7;
        const size_t r0 = row0 + 32 * c + 4 * tg;
        const int ch0 = h * 128 + 8 * d8;
        f32x4 la[4], lb4[4]; u32x4 kr[4], qr[4];
#pragma unroll
        for (int i = 0; i < 4; ++i) { la[i] = *(const f32x4*)(LF + (r0 + i) * 512 + ch0); lb4[i] = *(const f32x4*)(LF + (r0 + i) * 512 + ch0 + 4); kr[i] = *(const u32x4*)(KA + (r0 + i) * 512 + ch0);
            if (OUT) qr[i] = *(const u32x4*)(QAB + (r0 + i) * 1024 + ch0); }
        float bcum[4][8];
#pragma unroll
        for (int e = 0; e < 8; ++e) { float run = 0.f;
#pragma unroll
            for (int i = 0; i < 4; ++i) { run += (e < 4) ? la[i][e & 3] : lb4[i][e & 3]; bcum[i][e] = run; } }
        float excl[8], tot[8];
#pragma unroll
        for (int e = 0; e < 8; ++e) { const float loc = bcum[3][e]; float inc = loc;
#pragma unroll
            for (int o = 1; o < 8; o <<= 1) { const float y = __shfl_up(inc, o, 8); if (tg >= o) inc += y; }
            excl[e] = inc - loc; tot[e] = __shfl(inc, 7, 8); }
        if (tg == 0) { *(LAS f32x4*)(DECs + c * 128 + 8 * d8) = (f32x4){__expf(tot[0]), __expf(tot[1]), __expf(tot[2]), __expf(tot[3])};
                       *(LAS f32x4*)(DECs + c * 128 + 8 * d8 + 4) = (f32x4){__expf(tot[4]), __expf(tot[5]), __expf(tot[6]), __expf(tot[7])}; }
        unsigned khb[4][8];
#pragma unroll
        for (int i = 0; i < 4; ++i) {
            unsigned qw[4], kw[4];
#pragma unroll
            for (int e2 = 0; e2 < 4; ++e2) {
                const float b0 = excl[2 * e2] + bcum[i][2 * e2], b1 = excl[2 * e2 + 1] + bcum[i][2 * e2 + 1];
                const float k0 = bflo(kr[i][e2]), k1 = bfhi(kr[i][e2]);
                khb[i][2 * e2] = f2bf(k0 * __expf(tot[2 * e2] - b0)); khb[i][2 * e2 + 1] = f2bf(k1 * __expf(tot[2 * e2 + 1] - b1));
                if (OUT) { qw[e2] = pk2(bflo(qr[i][e2]) * __expf(b0), bfhi(qr[i][e2]) * __expf(b1)); kw[e2] = pk2(k0 * __expf(-b0), k1 * __expf(-b1)); }
            }
            if (OUT) { *(LAS u32x4*)(Qs + (32 * c + 4 * tg + i) * PC + 16 * d8) = (u32x4){qw[0], qw[1], qw[2], qw[3]};
                       *(LAS u32x4*)(Ks + (32 * c + 4 * tg + i) * PC + 16 * d8) = (u32x4){kw[0], kw[1], kw[2], kw[3]}; }
        }
#pragma unroll
        for (int e = 0; e < 8; ++e) *(LAS u32x2*)(KhT + (8 * d8 + e) * PT + (32 * c + 4 * tg) * 2) = (u32x2){khb[0][e] | (khb[1][e] << 16), khb[2][e] | (khb[3][e] << 16)};
#pragma unroll
        for (int i = 0; i < 4; ++i) { const int idx = tid + NTHREADS * i; *(LAS u32x4*)(VTs + (idx >> 4) * PT + (idx & 15) * 16) = vt[i]; }
    }
    __syncthreads();
#pragma unroll
    for (int cc = 0; cc < 4; ++cc) {
        {
            const int tb = 32 * cc;
            if (OUT) {
                f32x4 s00 = (f32x4){0.f, 0.f, 0.f, 0.f}, s01 = s00, s11 = s00;
#pragma unroll
                for (int kk = 0; kk < 4; ++kk) {
                    const bf16x8 kf0 = *(const LAS bf16x8*)(Ks + (tb + fr) * PC + (32 * kk + 8 * fq) * 2), kf1 = *(const LAS bf16x8*)(Ks + (tb + 16 + fr) * PC + (32 * kk + 8 * fq) * 2);
                    const bf16x8 qf0 = *(const LAS bf16x8*)(Qs + (tb + fr) * PC + (32 * kk + 8 * fq) * 2), qf1 = *(const LAS bf16x8*)(Qs + (tb + 16 + fr) * PC + (32 * kk + 8 * fq) * 2);
                    s00 = __builtin_amdgcn_mfma_f32_16x16x32_bf16(kf0, qf0, s00, 0, 0, 0);
                    s01 = __builtin_amdgcn_mfma_f32_16x16x32_bf16(kf0, qf1, s01, 0, 0, 0);
                    s11 = __builtin_amdgcn_mfma_f32_16x16x32_bf16(kf1, qf1, s11, 0, 0, 0);
                }
#pragma unroll
                for (int e = 0; e < 4; ++e) { const bool keep = (4 * fq + e) <= fr; s00[e] = keep ? s00[e] : 0.f; s11[e] = keep ? s11[e] : 0.f; }
                const bf16x8 pf0 = frag2(pack4(s00), (u32x2){0u, 0u}), pf1 = frag2(pack4(s01), pack4(s11));
                const bf16x8 vf = frag2(*(const LAS u32x2*)(VTs + (16 * wave + fr) * PT + (tb + 4 * fq) * 2), *(const LAS u32x2*)(VTs + (16 * wave + fr) * PT + (tb + 16 + 4 * fq) * 2));
                f32x4 o0 = __builtin_amdgcn_mfma_f32_16x16x32_bf16(vf, pf0, (f32x4){0.f, 0.f, 0.f, 0.f}, 0, 0, 0);
                f32x4 o1 = __builtin_amdgcn_mfma_f32_16x16x32_bf16(vf, pf1, (f32x4){0.f, 0.f, 0.f, 0.f}, 0, 0, 0);
#pragma unroll
                for (int kk = 0; kk < 4; ++kk) {
                    const bf16x8 sf = frag2(pack4(S[2 * kk]), pack4(S[2 * kk + 1]));
                    const bf16x8 q0 = frag2(*(const LAS u32x2*)(Qs + (tb + fr) * PC + (32 * kk + 4 * fq) * 2), *(const LAS u32x2*)(Qs + (tb + fr) * PC + (32 * kk + 16 + 4 * fq) * 2));
                    const bf16x8 q1 = frag2(*(const LAS u32x2*)(Qs + (tb + 16 + fr) * PC + (32 * kk + 4 * fq) * 2), *(const LAS u32x2*)(Qs + (tb + 16 + fr) * PC + (32 * kk + 16 + 4 * fq) * 2));
                    o0 = __builtin_amdgcn_mfma_f32_16x16x32_bf16(sf, q0, o0, 0, 0, 0);
                    o1 = __builtin_amdgcn_mfma_f32_16x16x32_bf16(sf, q1, o1, 0, 0, 0);
                }
                oacc[cc][0] = o0; oacc[cc][1] = o1;
            }
            const bf16x8 vb = *(const LAS bf16x8*)(VTs + (16 * wave + fr) * PT + (tb + 8 * fq) * 2);
#pragma unroll
            for (int dt = 0; dt < 8; ++dt) {
                const f32x4 dc = *(const LAS f32x4*)(DECs + cc * 128 + 16 * dt + 4 * fq);
                const bf16x8 kf = *(const LAS bf16x8*)(KhT + (16 * dt + fr) * PT + (tb + 8 * fq) * 2);
                S[dt] = __builtin_amdgcn_mfma_f32_16x16x32_bf16(kf, vb, S[dt] * dc, 0, 0, 0);
            }
        }
    }
    if (OUT) {
#pragma unroll
        for (int cc = 0; cc < 4; ++cc)
#pragma unroll
            for (int tt = 0; tt < 2; ++tt) { const f32x4 o = oacc[cc][tt]; float v = (o[0] * o[0] + o[1] * o[1]) + (o[2] * o[2] + o[3] * o[3]);
                v += __shfl_xor(v, 16); v += __shfl_xor(v, 32); if (fq == 0) SSQs[(32 * cc + 16 * tt + fr) * 8 + wave] = v; }
        __syncthreads();
#pragma unroll
        for (int cc = 0; cc < 4; ++cc)
#pragma unroll
            for (int tt = 0; tt < 2; ++tt) { const int t = 32 * cc + 16 * tt + fr;
                const f32x4 a = *(const LAS f32x4*)(SSQs + t * 8), b4 = *(const LAS f32x4*)(SSQs + t * 8 + 4);
                const float r = __builtin_amdgcn_rsqf((((a[0] + a[1]) + (a[2] + a[3])) + ((b4[0] + b4[1]) + (b4[2] + b4[3]))) * (1.0f / 128.0f) + 1e-6f);
                const int col = h * 128 + 16 * wave + 4 * fq;
                const u32x2 g = *(const u32x2*)(GA + (row0 + t) * 512 + col); const f32x4 o = oacc[cc][tt];
                u32x2 w; w.x = pk2(o[0] * r * bflo(g.x), o[1] * r * bfhi(g.x)); w.y = pk2(o[2] * r * bflo(g.y), o[3] * r * bfhi(g.y));
                if (dummy) *(u32x2*)((bf16_t*)(ws + WS_VB) + (row0 + t) * 512 + col) = w; else *(u32x2*)(QAB + (row0 + t) * 1024 + col) = w; }
    } else {
        if (tid < 128) dprod *= (DECs[tid] * DECs[128 + tid]) * (DECs[256 + tid] * DECs[384 + tid]);
    }
    }
    if (!OUT) {
#pragma unroll
        for (int dt = 0; dt < 8; ++dt) *(f32x4*)(stp + 16 * dt) = S[dt];
        if (tid < 128) DEC[(size_t)unit * 128 + tid] = dprod;
    }
}
__device__ __forceinline__ void hgrn_scan(const Params& p, int gtid, int nthr) {
    float* ST = (float*)(p.ws + WS_ST); const float* DEC = (const float*)(p.ws + OFF_DEC);
    for (int i = gtid; i < 16 * 4096; i += nthr) {
        const int bh = i >> 12, q4 = i & 4095, d = (4 * q4) & 127;
        f32x4 run = (f32x4){0.f, 0.f, 0.f, 0.f};
#pragma unroll 8
        for (int j = 0; j < 16; ++j) { f32x4* ps = (f32x4*)(ST + (size_t)(bh * 16 + j) * 16384 + 4 * q4); const f32x4 L = *ps; const f32x4 dc = *(const f32x4*)(DEC + (size_t)(bh * 16 + j) * 128 + d);
            *ps = run; run = dc * run + L; }
    }
}
__device__ __forceinline__ void attn_unit(const Params& p, int unit, LAS unsigned char* lds, int tid, int wave, int lane, bool dummy = false) {
    unsigned char* ws = p.ws;
    bf16_t* QAB = (bf16_t*)(ws + WS_QAB); const bf16_t* KB = (const bf16_t*)(ws + WS_KB); const bf16_t* VBT = (const bf16_t*)(ws + WS_IAT) + (size_t)512 * 128;
    const int bh = unit >> 5, qb = unit & 31, b = bh >> 2, h = bh & 3;
    const size_t row0 = (size_t)b * SEQ;
    constexpr int PC = 272, PT = 144;
    constexpr int ABUF = 64 * PC + 128 * PT;
    LAS unsigned* FL = (LAS unsigned*)(lds + 2 * ABUF);
    const int fr = lane & 15, fq = lane >> 4;
    const int tq = 128 * qb + 16 * wave + fr;
    bf16x8 qf[4];
    { const bf16_t* qp = QAB + (row0 + tq) * 1024 + 512 + h * 128 + 8 * fq;
#pragma unroll
      for (int kk = 0; kk < 4; ++kk) qf[kk] = *(const bf16x8*)(qp + 32 * kk); }
    f32x4 O[8];
#pragma unroll
    for (int dt = 0; dt < 8; ++dt) O[dt] = (f32x4){0.f, 0.f, 0.f, 0.f};
    float R = 0.f; bool wdone = false;
    if (tid < 8) FL[tid] = 0u;
    u32x4 kreg[2], vreg[2];
#define ATT_LOAD(s0_) do { _Pragma("unroll") for (int i = 0; i < 2; ++i) { const int idx = tid + NTHREADS * i; \
        kreg[i] = *(const u32x4*)(KB + (row0 + (s0_) + (idx >> 4)) * 512 + h * 128 + (idx & 15) * 8); \
        vreg[i] = *(const u32x4*)(VBT + (((row0 + (s0_)) >> 7) * 1024 + h * 128 + (idx >> 3)) * 128 + ((s0_) & 127) + (idx & 7) * 8); } } while (0)
#define ATT_STORE(buf_) do { _Pragma("unroll") for (int i = 0; i < 2; ++i) { const int idx = tid + NTHREADS * i; \
        *(LAS u32x4*)(lds + (buf_) * ABUF + (idx >> 4) * PC + (idx & 15) * 16) = kreg[i]; \
        *(LAS u32x4*)(lds + (buf_) * ABUF + 64 * PC + (idx >> 3) * PT + (idx & 7) * 16) = vreg[i]; } } while (0)
    ATT_LOAD(64 * (2 * qb + 1));
    ATT_STORE(0);
    ATT_LOAD(64 * (2 * qb));
    __syncthreads();
    int cur = 0;
    for (int kt0 = 2 * qb + 1; kt0 >= 0; --kt0, cur ^= 1) {
        const int s0 = 64 * kt0;
        { unsigned all = 1u;
#pragma unroll
          for (int i = 0; i < 8; ++i) all &= FL[i];
          if (all) break; }
        if (kt0 > 0) { ATT_STORE(cur ^ 1); if (kt0 > 1) ATT_LOAD(s0 - 128); }
        LAS unsigned char* Ks = lds + cur * ABUF; LAS unsigned char* VTs = Ks + 64 * PC;
        if (s0 < 128 * qb + 16 * wave + 15 && !wdone) {
        f32x4 z[4];
#pragma unroll
        for (int kt = 0; kt < 4; ++kt) { z[kt] = (f32x4){0.f, 0.f, 0.f, 0.f};
#pragma unroll
            for (int kk = 0; kk < 4; ++kk) { const bf16x8 kf = *(const LAS bf16x8*)(Ks + (16 * kt + fr) * PC + (32 * kk + 8 * fq) * 2);
                z[kt] = __builtin_amdgcn_mfma_f32_16x16x32_bf16(kf, qf[kk], z[kt], 0, 0, 0); } }
        f32x4 lk[4]; float T[4];
#pragma unroll
        for (int kt = 0; kt < 4; ++kt) {
#pragma unroll
            for (int e = 0; e < 4; ++e) { const float zz = z[kt][e]; const bool ok = (s0 + 16 * kt + 4 * fq + e) < tq;
                const float v = -(fmaxf(zz, 0.f) + __logf(1.0f + __expf(-fabsf(zz)))); lk[kt][e] = ok ? v : 0.f; }
            T[kt] = (lk[kt][0] + lk[kt][1]) + (lk[kt][2] + lk[kt][3]); }
        float run = R;
        f32x4 P[4];
#pragma unroll
        for (int kt = 3; kt >= 0; --kt) {
            const float t1 = __shfl_xor(T[kt], 16), t2 = __shfl_xor(T[kt], 32), t3 = __shfl_xor(T[kt], 48);
            const float g = (((fq ^ 1) > fq) ? t1 : 0.f) + (((fq ^ 2) > fq) ? t2 : 0.f) + (((fq ^ 3) > fq) ? t3 : 0.f);
            float suf = run + g;
#pragma unroll
            for (int e = 3; e >= 0; --e) { const bool ok = (s0 + 16 * kt + 4 * fq + e) < tq;
                P[kt][e] = ok ? __expf(lk[kt][e] + z[kt][e] + suf) : 0.f; suf += lk[kt][e]; }
            run += (T[kt] + t1) + (t2 + t3);
        }
        R = run;
#pragma unroll
        for (int kp = 0; kp < 2; ++kp) {
            const bf16x8 pf = frag2(pack4(P[2 * kp]), pack4(P[2 * kp + 1]));
#pragma unroll
            for (int dt = 0; dt < 8; ++dt) {
                const int vr = 32 * (dt >> 1) + 8 * (fr >> 2) + 4 * (dt & 1) + (fr & 3);
                const bf16x8 vf = frag2(*(const LAS u32x2*)(VTs + vr * PT + (32 * kp + 4 * fq) * 2), *(const LAS u32x2*)(VTs + vr * PT + (32 * kp + 16 + 4 * fq) * 2));
                O[dt] = __builtin_amdgcn_mfma_f32_16x16x32_bf16(vf, pf, O[dt], 0, 0, 0);
            }
        }
        { const bool done = R < -40.f; const unsigned long long bal = __ballot(done); wdone = (bal == ~0ull); if (lane == 0) FL[wave] = wdone ? 1u : 0u; }
        }
        __syncthreads();
    }
    bf16_t* op = dummy ? (bf16_t*)(ws + WS_VB) + (row0 + tq) * 512 + h * 128 + 8 * fq : QAB + (row0 + tq) * 1024 + 512 + h * 128 + 8 * fq;
#pragma unroll
    for (int k = 0; k < 4; ++k) { const u32x2 lo = pack4(O[2 * k]), hi = pack4(O[2 * k + 1]); *(u32x4*)(op + 32 * k) = (u32x4){lo.x, lo.y, hi.x, hi.y}; }
    __syncthreads();
}

__device__ __forceinline__ void gmix_phase(const Params& p, int o, LAS unsigned char* lds, int vcu, int G, int tid, int wave, int lane) {
    unsigned char* ws = p.ws;
    const bf16_t* VT = (const bf16_t*)(ws + WS_VT); bf16_t* U = (bf16_t*)(ws + WS_U);
    const float* S1 = (const float*)(ws + WS_LNP + (size_t)(2 * o) * LNP_STRIDE); const float* S2 = (const float*)(ws + WS_LNP + (size_t)(2 * o + 1) * LNP_STRIDE);
    const float* lng = p.in[I_LNG] + o * 3072; const float* lnb = p.in[I_LNB] + o * 3072;
    constexpr int PITCH = 272;
    LAS unsigned char* Wp = lds; LAS unsigned char* VTs = lds + 128 * PITCH;
    LAS float* AL = (LAS float*)(lds + 128 * PITCH + 192 * PITCH); LAS float* BE = AL + 128;
    LAS float* MUA = BE + 128; LAS float* RSA = MUA + 512;
    LAS float* LG = RSA + 512; LAS float* LBt = LG + 384;
    const int fr = lane & 15, fq = lane >> 4;
    const int wt = tid >> 2, wsq = tid & 3;
    f32x4 wreg[8];
    u32x4 vreg[6]; u32x4 ureg[6];
#define GM_LOADV(n_, g_, half_) do { _Pragma("unroll") for (int i = 0; i < 6; ++i) { const int idx = tid + NTHREADS * i; \
        vreg[i] = *(const u32x4*)(VT + ((size_t)(n_) * 3072 + (g_) * 384 + (half_) * 192 + (idx >> 4)) * 128 + (idx & 15) * 8); } } while (0)
#define GM_STOREV() do { _Pragma("unroll") for (int i = 0; i < 6; ++i) { const int idx = tid + NTHREADS * i; *(LAS u32x4*)(VTs + (idx >> 4) * PITCH + (idx & 15) * 16) = vreg[i]; } } while (0)
#define GM_LOADU(dst_, n_, g_, half_) do { _Pragma("unroll") for (int kp = 0; kp < 6; ++kp) dst_[kp] = *(const u32x4*)(U + (size_t)((n_) * 128 + 16 * wave + fr) * 3072 + (g_) * 384 + (half_) * 192 + 32 * kp + 8 * fq); } while (0)
    if (vcu < 1024) GM_LOADV(vcu >> 3, vcu & 7, 0);
    __syncthreads();
    {
        const int k = tid >> 7, tk = tid & 127, unit = vcu + k * G;
        if (unit < 1024 && k < 4) { const size_t tok = (size_t)(unit >> 3) * 128 + tk; float a1 = 0.f, a2 = 0.f;
#pragma unroll
            for (int j = 0; j < 6; ++j) { const f32x4 x = *(const f32x4*)(S1 + tok * 24 + 4 * j), y = *(const f32x4*)(S2 + tok * 24 + 4 * j); a1 += (x[0] + x[1]) + (x[2] + x[3]); a2 += (y[0] + y[1]) + (y[2] + y[3]); }
            const float mu = a1 * (1.0f / 3072.0f); const float var = a2 * (1.0f / 3072.0f) - mu * mu; MUA[tid] = mu; RSA[tid] = __builtin_amdgcn_rsqf(fmaxf(var, 0.f) + 1e-6f); }
    }
    int kslot = 0;
    for (int unit = vcu; unit < 1024; unit += G, ++kslot) {
        const int n = unit >> 3, g = unit & 7, T0 = n * 128;
        __syncthreads();
        GM_STOREV();
        GM_LOADU(ureg, n, g, 0);
        { const float* wrow = p.in[I_GMWS] + ((size_t)(o * 8 + g) * 128 + wt) * 128 + 32 * wsq;
#pragma unroll
          for (int j = 0; j < 8; ++j) wreg[j] = *(const f32x4*)(wrow + 4 * j); }
        const LAS float* MU = MUA + 128 * kslot; const LAS float* RS = RSA + 128 * kslot;
        {
            float al = 0.f, be = 0.f;
#pragma unroll
            for (int j = 0; j < 4; ++j) {
                unsigned pk[4];
#pragma unroll
                for (int e2 = 0; e2 < 4; ++e2) {
                    unsigned bits[2];
#pragma unroll
                    for (int hh = 0; hh < 2; ++hh) {
                        const int e = 2 * e2 + hh, s = 32 * wsq + 8 * j + e;
                        float w = wreg[2 * j + (e >> 2)][e & 3]; w = (s <= wt) ? w : 0.f; be += w;
                        bits[hh] = f2bf(w * RS[s]); al += __uint_as_float(bits[hh] << 16) * MU[s];
                    }
                    pk[e2] = bits[0] | (bits[1] << 16);
                }
                *(LAS u32x4*)(Wp + wt * PITCH + (32 * wsq + 8 * j) * 2) = (u32x4){pk[0], pk[1], pk[2], pk[3]};
            }
            al += __shfl_xor(al, 1); al += __shfl_xor(al, 2); be += __shfl_xor(be, 1); be += __shfl_xor(be, 2);
            if (wsq == 0) { AL[wt] = al; BE[wt] = be; }
        }
        GM_LOADV(n, g, 1);
        __syncthreads();
        const int t = 16 * wave + fr; const float al = AL[t], be = BE[t], bsv = p.in[I_GMBS][(o * 8 + g) * 128 + t];
        const int nks = ((16 * wave + 15) >> 5) + 1;
        const float* lngu = lng; const float* lnbu = lnb; asm volatile("" : "+s"(lngu), "+s"(lnbu));
#pragma unroll
        for (int half = 0; half < 2; ++half) {
            const int cg0 = g * 384 + half * 192;
            if (half) { __syncthreads();
                GM_STOREV(); GM_LOADU(ureg, n, g, 1);
                if (unit + G < 1024) GM_LOADV((unit + G) >> 3, (unit + G) & 7, 0);
                __syncthreads(); }
            f32x4 acc[12];
#pragma unroll
            for (int ct = 0; ct < 12; ++ct) acc[ct] = (f32x4){0.f, 0.f, 0.f, 0.f};
            for (int ks = 0; ks < nks; ++ks) {
                const bf16x8 bfrag = *(const LAS bf16x8*)(Wp + (16 * wave + fr) * PITCH + (32 * ks + 8 * fq) * 2);
#pragma unroll
                for (int ct = 0; ct < 12; ++ct) { const bf16x8 afrag = *(const LAS bf16x8*)(VTs + (32 * (ct >> 1) + 8 * (fr >> 2) + 4 * (ct & 1) + (fr & 3)) * PITCH + (32 * ks + 8 * fq) * 2);
                    acc[ct] = __builtin_amdgcn_mfma_f32_16x16x32_bf16(afrag, bfrag, acc[ct], 0, 0, 0); }
            }
#pragma unroll
            for (int kp = 0; kp < 6; ++kp) {
                const int cl = half * 192 + 32 * kp + 8 * fq, cg = g * 384 + cl;
                const f32x4 lg0 = *(const f32x4*)(lngu + cg), lg1 = *(const f32x4*)(lngu + cg + 4), lb0 = *(const f32x4*)(lnbu + cg), lb1 = *(const f32x4*)(lnbu + cg + 4);
                const u32x4 uu = ureg[kp]; const f32x4 a0 = acc[2 * kp], a1 = acc[2 * kp + 1];
                u32x4 w;
                w.x = pk2(bflo(uu.x) * (lg0[0] * (a0[0] - al) + lb0[0] * be + bsv), bfhi(uu.x) * (lg0[1] * (a0[1] - al) + lb0[1] * be + bsv));
                w.y = pk2(bflo(uu.y) * (lg0[2] * (a0[2] - al) + lb0[2] * be + bsv), bfhi(uu.y) * (lg0[3] * (a0[3] - al) + lb0[3] * be + bsv));
                w.z = pk2(bflo(uu.z) * (lg1[0] * (a1[0] - al) + lb1[0] * be + bsv), bfhi(uu.z) * (lg1[1] * (a1[1] - al) + lb1[1] * be + bsv));
                w.w = pk2(bflo(uu.w) * (lg1[2] * (a1[2] - al) + lb1[2] * be + bsv), bfhi(uu.w) * (lg1[3] * (a1[3] - al) + lb1[3] * be + bsv));
                *(u32x4*)(U + (size_t)(T0 + t) * 3072 + cg) = w;
            }
            (void)cg0;
        }
    }
#undef GM_LOADV
#undef GM_STOREV
#undef GM_LOADU
}

constexpr size_t OFF_BAR = 512 * 1024;
#define XB_TMO      128
#define XB_XCNT(j)  (256  + 64 * (j))
#define XB_XSUB(j)  (1280 + 64 * (j))
#define XB_XGEN(j)  (2304 + 64 * (j))
#define XB_TOP      3328
#define XB_TOPGEN   3392
#define XCD_BAR_WORDS 3456
#define XB_SPIN_CAP (1u << 18)

__device__ __forceinline__ unsigned xb_ld(unsigned* p)              { return __hip_atomic_load(p, __ATOMIC_RELAXED, __HIP_MEMORY_SCOPE_AGENT); }
__device__ __forceinline__ unsigned xb_add(unsigned* p, unsigned v) { return __hip_atomic_fetch_add(p, v, __ATOMIC_RELAXED, __HIP_MEMORY_SCOPE_AGENT); }
__device__ __forceinline__ unsigned xb_xcc_id() { return (unsigned)__builtin_amdgcn_s_getreg((3 << 11) | 20) & 0xFu; }
#define XB_SPIN(cond, bar) do { unsigned _sp = 0; while (cond) { __builtin_amdgcn_s_sleep(1); \
    if ((++_sp & 255u) == 0u) { if (xb_ld(&(bar)[XB_TMO])) break; if (_sp > XB_SPIN_CAP) { atomicAdd(&(bar)[XB_TMO], 1u); break; } } } } while (0)

struct XcdBarrier {
    unsigned* bar; unsigned x;
    volatile LAS unsigned* st;
};

__device__ __forceinline__ XcdBarrier xcd_barrier_post(unsigned* bar, volatile LAS unsigned* st) {
    XcdBarrier b; b.bar = bar; b.x = xb_xcc_id(); b.st = st;
    if (threadIdx.x == 0) (void)xb_add(&bar[XB_XCNT(b.x)], 1u);
    return b;
}
__device__ __forceinline__ void xcd_barrier_complete(unsigned* bar, unsigned x, unsigned& nloc, unsigned& nx) {
    const unsigned G = gridDim.x * gridDim.y * gridDim.z;
    unsigned sum, cnt, mine, sp = 0u;
    for (;;) {
        sum = 0u; cnt = 0u; mine = 0u;
#pragma unroll
        for (unsigned j = 0; j < 16; ++j) { const unsigned c = xb_ld(&bar[XB_XCNT(j)]); sum += c; cnt += (c > 0u) ? 1u : 0u; mine = (j == x) ? c : mine; }
        if (sum == G) break;
        __builtin_amdgcn_s_sleep(1);
        if ((++sp & 255u) == 0u) { if (xb_ld(&bar[XB_TMO])) break; if (sp > XB_SPIN_CAP) { atomicAdd(&bar[XB_TMO], 1u); break; } }
    }
    nloc = mine > 0u ? mine : 1u; nx = cnt > 0u ? cnt : 1u;
}

__device__ __forceinline__ void xcd_barrier(const XcdBarrier& b) {
    asm volatile("s_waitcnt vmcnt(0)" ::: "memory");
    __syncthreads();
    if (threadIdx.x == 0) {
        unsigned* bar = b.bar;
        __builtin_amdgcn_s_waitcnt(0);
        unsigned nloc = b.st[0], nx = b.st[1];
        if (nloc == 0u) { xcd_barrier_complete(bar, b.x, nloc, nx); b.st[0] = nloc; b.st[1] = nx; }
        const unsigned old = xb_add(&bar[XB_XSUB(b.x)], 1u);
        const unsigned gen = old / nloc;
        if (old + 1u == (gen + 1u) * nloc) {
            __builtin_amdgcn_fence(__ATOMIC_RELEASE, "agent");
            asm volatile("s_waitcnt vmcnt(0)" ::: "memory");
            const unsigned og = xb_add(&bar[XB_TOP], 1u);
            const unsigned tg = og / nx;
            if (og + 1u == (tg + 1u) * nx) xb_add(&bar[XB_TOPGEN], 1u);
            else XB_SPIN(xb_ld(&bar[XB_TOPGEN]) == tg, bar);
            __builtin_amdgcn_fence(__ATOMIC_ACQUIRE, "agent");
            xb_add(&bar[XB_XGEN(b.x)], 1u);
            asm volatile("s_waitcnt vmcnt(0)" ::: "memory");
        } else {
            XB_SPIN(xb_ld(&bar[XB_XGEN(b.x)]) == gen, bar);
            __builtin_amdgcn_fence(__ATOMIC_ACQUIRE, "agent");
            asm volatile("s_waitcnt vmcnt(0)" ::: "memory");
        }
    }
    __syncthreads();
}

template <class Sched> __device__ __forceinline__ void rstd_table(const Sched& S, const float* ssq, bool cols, LAS float* tab, int tid) {
    pg8::Unit u;
    for (int i = 0; S.next(i, u); ++i) {
        const int base = (cols ? u.pn : u.pm) * 256;
#pragma unroll
        for (int k = 0; k < 2; ++k) { const int idx = tid + NTHREADS * k, r = idx >> 2, qd = idx & 3;
            const f32x4 v = *(const f32x4*)(ssq + (size_t)(base + r) * 16 + 4 * qd); float t = (v[0] + v[1]) + (v[2] + v[3]);
            t += __shfl_xor(t, 1); t += __shfl_xor(t, 2);
            if (qd == 0) tab[i * 256 + r] = __builtin_amdgcn_rsqf(t * (1.0f / 1024.0f) + 1e-6f); }
    }
    __syncthreads();
}
#ifndef PROBE
#define PROBE 0
#endif
#define REP(mask) for (int rep_ = ((PROBE) & (mask)) ? 0 : 1; rep_ < 2; ++rep_)
__global__ void __launch_bounds__(NTHREADS, 2) fwd(Params p) {
    extern __shared__ __attribute__((aligned(16))) unsigned char lds_raw[];
    LAS unsigned char* lds = (LAS unsigned char*)lds_raw;
    cg::grid_group grid = cg::this_grid();
    int tid = threadIdx.x, lane = tid & 63;
    const int wave = __builtin_amdgcn_readfirstlane(tid >> 6);
    const int G = gridDim.x, bx = blockIdx.x;
    const int vcu = (G % 8 == 0) ? (bx % 8) * (G / 8) + bx / 8 : bx;
    const int gw = vcu * NWAVES + wave, ngw = G * NWAVES;
    Params q = p;
    LAS float* RST = (LAS float*)(lds + 131072);
    volatile LAS unsigned* bst = (volatile LAS unsigned*)(lds + LDS_BYTES - 64);
    if (tid < 2) bst[tid] = 0u;
    __syncthreads();
    XcdBarrier xbar = xcd_barrier_post((unsigned*)(p.ws + OFF_BAR), bst);
    int ph = 0;
#define PHASE_BEGIN() (ph >= p.ph_lo && ph < p.ph_hi)
#define PHASE_END() do { if (ph >= p.ph_lo && ph + 1 < p.ph_hi) { REP(32) { xcd_barrier(xbar); } } ++ph; } while (0)
#define LAUNDER() asm volatile("" : "+s"(q.out), "+s"(q.ws), "+v"(tid), "+v"(lane)); \
    unsigned char* ws = q.ws; float* SSQ = (float*)(ws + WS_SSQ); bf16_t* XB = (bf16_t*)(ws + WS_XB); (void)SSQ; (void)XB

    if (PHASE_BEGIN()) {
        LAUNDER();
        if (bx == 0) { float* LB = (float*)(ws + OFF_LB); const float* lg = q.in[I_LBL];
            const float l0 = lg[tid], l1 = lg[512 + tid], mx = fmaxf(l0, l1), e0 = __expf(l0 - mx), e1 = __expf(l1 - mx), inv = 1.0f / (e0 + e1);
            const float c0 = e0 * inv, c1 = c0 + e1 * inv; LB[tid] = c0 - c0; LB[512 + tid] = c1 - c0; }
        for (int row = gw; row < M; row += ngw) {
            const f32x4* xr = (const f32x4*)(q.in[I_X] + (size_t)row * D) + lane; f32x4 v[4]; float s = 0.f;
#pragma unroll
            for (int j = 0; j < 4; ++j) { v[j] = xr[64 * j]; s += (v[j][0] * v[j][0] + v[j][1] * v[j][1]) + (v[j][2] * v[j][2] + v[j][3] * v[j][3]); }
            s = wave_sum(s); if (lane < 4) *(f32x4*)(SSQ + (size_t)row * 16 + 4 * lane) = (f32x4){lane == 0 ? s : 0.f, 0.f, 0.f, 0.f};
            u32x2* o8 = (u32x2*)(XB + (size_t)row * D) + lane;
#pragma unroll
            for (int j = 0; j < 4; ++j) { u32x2 w; w.x = pk2(v[j][0], v[j][1]); w.y = pk2(v[j][2], v[j][3]); o8[64 * j] = w; }
        }
        conv_chore(q, 0, 1 | 2 | 4, lds, gw, ngw, wave, lane);
    }
    if (p.ph_lo < 0) grid.sync();
    PHASE_END();

    for (int layer = 0; layer < 4; ++layer) {
        const int e = layer >> 1;
        const bool grpA = ((bx >> 3) & 1) == 0;
        if ((layer & 1) == 0) {
            if (PHASE_BEGIN()) REP(2) {
                { LAUNDER(); const float* ssq_mix = SSQ + (size_t)(2 * layer) * M * 16;
                  pg8::Gemm g{XB, (const bf16_t*)(ws + WS_WA), M, 2560, 1024}; pg8::StaticOrder S; S.init(M, 2560, G, bx);
                  rstd_table(S, ssq_mix, false, RST, tid); pg8::EpiProj E{RST, (const float*)(ws + OFF_LB) + e * 512, q.in[I_HON] + e * 512, (bf16_t*)(ws + WS_QAB), (bf16_t*)(ws + WS_KA), (float*)(ws + WS_LF), (bf16_t*)(ws + WS_GA), (bf16_t*)(ws + WS_KB), 0};
                  pg8::gemm_phase<pg8::EpiProj, pg8::StaticOrder, true, true>(lds, g, S, E); }
                { LAUNDER(); const float* ssq_mix = SSQ + (size_t)(2 * layer) * M * 16;
                  pg8::Gemm g{(const bf16_t*)(ws + WS_WB), XB, 1024, M, 1024}; pg8::StaticOrder S; S.init(1024, M, G, bx);
                  rstd_table(S, ssq_mix, true, RST, tid); pg8::EpiT<0> E{RST, (bf16_t*)(ws + WS_IAT), 1024, nullptr, nullptr};
                  pg8::gemm_phase<pg8::EpiT<0>, pg8::StaticOrder, true, true>(lds, g, S, E); }
            }
            PHASE_END();
            if (PHASE_BEGIN()) { REP(4) { LAUNDER(); for (int u = vcu; u < 256; u += G) hgrn_unit<false>(q, u, lds, tid, wave, lane); } REP(8) { LAUNDER(); for (int u = vcu; u < 512; u += G) attn_unit(q, (u & ~31) | (31 - (u & 31)), lds, tid, wave, lane, rep_ == 0); } }
            PHASE_END();
            if (PHASE_BEGIN()) { LAUNDER(); hgrn_scan(q, vcu * NTHREADS + tid, G * NTHREADS); }
            PHASE_END();
            if (PHASE_BEGIN()) REP(16) { LAUNDER(); for (int u = vcu; u < 256; u += G) hgrn_unit<true>(q, u, lds, tid, wave, lane, rep_ == 0); }
            PHASE_END();
        } else {
            if (PHASE_BEGIN()) REP(2) {
                { LAUNDER(); const float* ssq_mix = SSQ + (size_t)(2 * layer) * M * 16;
                  pg8::Gemm g{XB, (const bf16_t*)(ws + WS_WA), M, 3072, 1024}; pg8::StaticOrder S; S.init(M, 3072, G, bx);
                  rstd_table(S, ssq_mix, false, RST, tid); pg8::EpiRow<1> E{RST, (bf16_t*)(ws + WS_U), 3072};
                  pg8::gemm_phase<pg8::EpiRow<1>, pg8::StaticOrder, true, true>(lds, g, S, E); }
                { LAUNDER(); const float* ssq_mix = SSQ + (size_t)(2 * layer) * M * 16;
                  pg8::Gemm g{(const bf16_t*)(ws + WS_WB), XB, 3072, M, 1024}; pg8::StaticOrder S; S.init(3072, M, G, bx);
                  rstd_table(S, ssq_mix, true, RST, tid); pg8::EpiT<1> E{RST, (bf16_t*)(ws + WS_VT), 3072, (float*)(ws + WS_LNP + (size_t)(2 * e) * LNP_STRIDE), (float*)(ws + WS_LNP + (size_t)(2 * e + 1) * LNP_STRIDE)};
                  pg8::gemm_phase<pg8::EpiT<1>, pg8::StaticOrder, true, true>(lds, g, S, E); }
            }
            PHASE_END();
            if (PHASE_BEGIN()) { LAUNDER(); gmix_phase(q, e, lds, vcu, G, tid, wave, lane); }
            PHASE_END();
        }
        for (int r = 0; r < 2; ++r) {
            if (r == 1) {
                if (PHASE_BEGIN()) { LAUNDER();
                    if (grpA) { conv_chore(q, layer + 1, 2, lds, gw, ngw, wave, lane); __syncthreads(); }
                    { pg8::Gemm g{XB, (const bf16_t*)(ws + WS_W1), M, 4096, 1024}; pg8::StaticOrder S; S.init(M, 4096, G, bx);
                    rstd_table(S, SSQ + (size_t)(2 * layer + 1) * M * 16, false, RST, tid); pg8::EpiRow<2> E{RST, (bf16_t*)(ws + WS_H), 4096};
                    pg8::gemm_phase<pg8::EpiRow<2>, pg8::StaticOrder, true, true>(lds, g, S, E); }
                    if (!grpA) { __syncthreads(); conv_chore(q, layer + 1, 2, lds, gw, ngw, wave, lane); } }
                PHASE_END();
            }
            if (PHASE_BEGIN()) {
                LAUNDER(); const int rep_ = 1;
                if (grpA) { if (r == 0) { conv_chore(q, layer, 8, lds, gw, ngw, wave, lane); conv_chore(q, layer + 1, 1, lds, gw, ngw, wave, lane); } else conv_chore(q, layer + 1, 4, lds, gw, ngw, wave, lane); __syncthreads(); }
                const bf16_t* A = r ? (const bf16_t*)(ws + WS_H) : (const bf16_t*)(ws + WS_ACT);
                const int K = r ? 4096 : ((layer & 1) ? 3072 : 1024);
                pg8::Gemm g{A, (const bf16_t*)(ws + (r ? WS_W2 : WS_WO)), M, 1024, K}; pg8::StaticOrder S; S.init(M, 1024, G, bx);
                pg8::EpiRes E{XB, SSQ + (size_t)(2 * layer + 1 + r) * M * 16};
                pg8::gemm_phase<pg8::EpiRes, pg8::StaticOrder, true, true>(lds, g, S, E);
                if (!grpA) { __syncthreads(); if (r == 0) { conv_chore(q, layer, 8, lds, gw, ngw, wave, lane); conv_chore(q, layer + 1, 1, lds, gw, ngw, wave, lane); } else conv_chore(q, layer + 1, 4, lds, gw, ngw, wave, lane); }
            }
            PHASE_END();
        }
    }
    if (PHASE_BEGIN()) {
        LAUNDER();
        const float* fn = q.in[I_FN]; const float* sq = SSQ + (size_t)8 * M * 16;
        for (int row = gw; row < M; row += ngw) {
            const float r = pg8::rstd1024(sq + (size_t)row * 16);
            f32x4* xr = (f32x4*)(q.out + (size_t)row * D) + lane; const u32x2* xb = (const u32x2*)(XB + (size_t)row * D) + lane;
#pragma unroll
            for (int j = 0; j < 4; ++j) { const f32x4 gn = *((const f32x4*)fn + lane + 64 * j); const u32x2 w = xb[64 * j];
                xr[64 * j] = (f32x4){bflo(w.x), bfhi(w.x), bflo(w.y), bfhi(w.y)} * r * gn; }
        }
    }
}
constexpr int N_PHASES = 1 + 3 + 2 * (4 + 3) + 2 * (3 + 3) + 1;

extern "C" void kernel_launch(void* const* d_in, const int* in_sizes, int n_in, void* d_out, int out_size, void* d_ws, size_t ws_size, hipStream_t stream) {
    static int grid = 0;
    if (grid == 0) {
        if (n_in != 16 || out_size != M * D || ws_size < WS_END) { fprintf(stderr, "kernel_launch: unexpected shapes: n_in %d out %d ws %zu (need %zu)\n", n_in, out_size, ws_size, (size_t)WS_END); grid = -1; return; }
        int dev = 0, cus = 0, per_cu = 0;
        hipGetDevice(&dev); hipDeviceGetAttribute(&cus, hipDeviceAttributeMultiprocessorCount, dev);
        hipFuncSetAttribute((const void*)fwd, hipFuncAttributeMaxDynamicSharedMemorySize, LDS_BYTES);
        hipOccupancyMaxActiveBlocksPerMultiprocessor(&per_cu, (const void*)fwd, NTHREADS, LDS_BYTES);
        (void)hipGetLastError();
        if (per_cu < 1) per_cu = 1;
        grid = cus * per_cu;
        if (grid < 256 || (grid & 7)) { fprintf(stderr, "kernel_launch: grid %d unsupported (needs a multiple of 8, >= 256)\n", grid); grid = -1; return; }
        fprintf(stderr, "kernel_launch: grid %d (cus %d x %d)\n", grid, cus, per_cu);
    }
    if (grid < 0) return;
    Params p{};
    for (int i = 0; i < 16; ++i) p.in[i] = (const float*)d_in[i];
    p.out = (float*)d_out; p.ws = (unsigned char*)d_ws; p.ph_lo = 0; p.ph_hi = 1 << 20;
    if (hipMemsetAsync((char*)d_ws + OFF_BAR, 0, 16384, stream) != hipSuccess) fprintf(stderr, "kernel_launch: memset of barrier words failed\n");
    void* args[] = {&p};
    hipError_t err = hipLaunchCooperativeKernel((const void*)fwd, dim3(grid), dim3(NTHREADS), args, LDS_BYTES, stream);
    if (err != hipSuccess) fprintf(stderr, "kernel_launch: cooperative launch failed: %s (grid %d)\n", hipGetErrorString(err), grid);
}
```

```cpp
#ifndef PROBE
#define PROBE 0
#endif
#include <hip/hip_runtime.h>
#include <hip/hip_cooperative_groups.h>
#include <cstdio>
#include <cstdint>
namespace cg = cooperative_groups;
namespace pg8 {
#define PG8_LAS __attribute__((address_space(3)))
typedef unsigned short bf16_t;
typedef short bf16x8 __attribute__((ext_vector_type(8)));
typedef float f32x4 __attribute__((ext_vector_type(4)));
typedef unsigned u32x4 __attribute__((ext_vector_type(4)));
constexpr int BM = 256, BK = 64, HALF = 128, HTB = HALF * BK * 2  , STAGE_BYTES = 8 * HTB, NXCD = 8, WGM = 8;

__host__ __device__ __forceinline__ int lds_byte(int r, int c) { const int st = (r >> 4) * 2 + (c >> 5), rr = r & 15, cc = c & 31, ob = rr * 64 + cc * 2; return st * 1024 + (ob ^ (((ob >> 9) & 1) << 5)); }
__host__ __device__ __forceinline__ void stage_rc(int b, int& R, int& C) { const int st = b / 1024, sb = b % 1024, swz = sb ^ (((sb >> 9) & 1) << 5); R = (st >> 1) * 16 + swz / 64; C = (st & 1) * 32 + (swz % 64) / 2; }
__host__ __device__ __forceinline__ int perm32(int rho) { const int n = rho >> 4, i = rho & 15; return 8 * (i >> 2) + 4 * n + (i & 3); }

struct Unit { int pm, pn, ord; };
struct Gemm { const bf16_t* A; const bf16_t* Bt; int M, N, K; };

struct StaticOrder {
    int nM, nN, nwg, G, c;
    __host__ __device__ void init(int M, int N, int G_, int c_) { nM = M / BM; nN = N / BM; nwg = nM * nN; G = G_; c = c_; }
    __host__ __device__ bool next(int i, Unit& u) const {
        const long L = (long)i * G + c; if (L >= nwg) return false;
        int wgid = (int)L; { const int q = nwg / NXCD, r = nwg % NXCD, xcd = wgid % NXCD, off = wgid / NXCD; wgid = (xcd < r ? xcd * (q + 1) : r * (q + 1) + (xcd - r) * q) + off; }
        const int nig = WGM * nN, gid = wgid / nig, fm = gid * WGM, gsz = (nM - fm) < WGM ? (nM - fm) : WGM;
        u.pm = fm + ((wgid % nig) % gsz); u.pn = (wgid % nig) / gsz; u.ord = i; return true;
    }
    __device__ __forceinline__ void a_ready(const Unit&) const {}
    __device__ __forceinline__ void done(const Unit&) const {}
};

__device__ __forceinline__ unsigned cvt_pk_bf16(float lo, float hi) { unsigned r; asm volatile("v_cvt_pk_bf16_f32 %0, %1, %2" : "=v"(r) : "v"(lo), "v"(hi)); return r; }
typedef float f32x2 __attribute__((ext_vector_type(2)));
__device__ __forceinline__ f32x2 gelu_pk(f32x2 v) {
    const f32x2 av = __builtin_elementwise_abs(v), d = av * 0.2316418882f + 1.0f;
    f32x2 t; t.x = __builtin_amdgcn_rcpf(d.x); t.y = __builtin_amdgcn_rcpf(d.y);
    f32x2 q = t * 0.5307027145f + (-0.7265760135f); q = q * t + 0.7107068705f; q = q * t + (-0.142248368f); q = q * t + 0.127414796f; q = q * t;
    const f32x2 s = (v * v) * (-0.72134752044f);
    f32x2 e; e.x = __builtin_amdgcn_exp2f(s.x); e.y = __builtin_amdgcn_exp2f(s.y);
    const f32x2 m = v * (q * e), r = v - m;
    f32x2 o; o.x = v.x < 0.f ? m.x : r.x; o.y = v.y < 0.f ? m.y : r.y; return o;
}
typedef unsigned u32x2 __attribute__((ext_vector_type(2)));
__device__ __forceinline__ float rstd1024(const float* s16) { const f32x4 a = *(const f32x4*)s16, b = *(const f32x4*)(s16 + 4), c = *(const f32x4*)(s16 + 8), d = *(const f32x4*)(s16 + 12);
    const float t = (((a[0] + a[1]) + (a[2] + a[3])) + ((b[0] + b[1]) + (b[2] + b[3]))) + (((c[0] + c[1]) + (c[2] + c[3])) + ((d[0] + d[1]) + (d[2] + d[3])));
    return __builtin_amdgcn_rsqf(t * (1.0f / 1024.0f) + 1e-6f); }
__device__ __forceinline__ float sigm(float v) { return __builtin_amdgcn_rcpf(1.0f + __expf(-v)); }
__device__ __forceinline__ u32x4 pack8(const f32x4& a, const f32x4& b) { u32x4 w; w.x = cvt_pk_bf16(a[0], a[1]); w.y = cvt_pk_bf16(a[2], a[3]); w.z = cvt_pk_bf16(b[0], b[1]); w.w = cvt_pk_bf16(b[2], b[3]); return w; }

struct EpiProj {
    static constexpr bool PERM = true, AFTER_DRAIN = false, IDEMP = true;
    const PG8_LAS float* rst; const float* lb; const float* gnorm; bf16_t* QAB; bf16_t* KA; float* LF; bf16_t* GA; bf16_t* KB; int seg0;
    __device__ __forceinline__ void operator()(const f32x4 (&acc)[2][2][4][2], const Unit& u, int wr, int wc, int fr, int fq) const {
        asm volatile("" : "+v"(fr), "+v"(fq));
        const int seg = seg0 + (u.pn >> 1);
        const int cb = (u.pn & 1) * 256 + wc * 32 + 8 * fq;
#pragma unroll
        for (int ai = 0; ai < 2; ++ai)
#pragma unroll
            for (int m = 0; m < 4; ++m) {
                const size_t row = (size_t)u.pm * BM + ai * HALF + wr * 64 + m * 16 + fr;
                const float rs = rst[u.ord * 256 + ai * HALF + wr * 64 + m * 16 + fr];
#pragma unroll
                for (int bj = 0; bj < 2; ++bj) {
                    const int c = cb + bj * HALF;
                    f32x4 v0 = acc[ai][bj][m][0] * rs, v1 = acc[ai][bj][m][1] * rs;
                    if (seg == 0) {
#pragma unroll
                        for (int e = 0; e < 4; ++e) { v0[e] = v0[e] * sigm(v0[e]); v1[e] = v1[e] * sigm(v1[e]); }
                        *(u32x4*)(QAB + row * 1024 + c) = pack8(v0, v1);
                    } else if (seg == 1) {
                        const f32x4 l0 = *(const f32x4*)(lb + c), l1 = *(const f32x4*)(lb + c + 4);
                        f32x4 lf0, lf1, k0, k1;
#pragma unroll
                        for (int e = 0; e < 4; ++e) {
                            const float s0 = sigm(v0[e]), s1 = sigm(v1[e]);
                            lf0[e] = __logf(l0[e] + (1.0f - l0[e]) * s0); lf1[e] = __logf(l1[e] + (1.0f - l1[e]) * s1);
                            k0[e] = (1.0f - l0[e]) * sigm(-v0[e]); k1[e] = (1.0f - l1[e]) * sigm(-v1[e]);
                        }
                        *(f32x4*)(LF + row * 512 + c) = lf0; *(f32x4*)(LF + row * 512 + c + 4) = lf1;
                        *(u32x4*)(KA + row * 512 + c) = pack8(k0, k1);
                    } else if (seg == 4) {
                        const f32x4 g0 = *(const f32x4*)(gnorm + c), g1 = *(const f32x4*)(gnorm + c + 4);
#pragma unroll
                        for (int e = 0; e < 4; ++e) { v0[e] = g0[e] * v0[e] * sigm(v0[e]); v1[e] = g1[e] * v1[e] * sigm(v1[e]); }
                        *(u32x4*)(GA + row * 512 + c) = pack8(v0, v1);
                    } else if (seg == 2) {
                        v0 = v0 * 0.08838834764831845f; v1 = v1 * 0.08838834764831845f;
                        *(u32x4*)(QAB + row * 1024 + 512 + c) = pack8(v0, v1);
                    } else {
                        *(u32x4*)(KB + row * 512 + c) = pack8(v0, v1);
                    }
                }
                asm volatile("" ::: "memory");
            }
    }
};

template <int ACT> struct EpiRow {
    static constexpr bool PERM = true, AFTER_DRAIN = false, IDEMP = true;
    const PG8_LAS float* rst; bf16_t* O; int ldc;
    __device__ __forceinline__ void operator()(const f32x4 (&acc)[2][2][4][2], const Unit& u, int wr, int wc, int fr, int fq) const {
        asm volatile("" : "+v"(fr), "+v"(fq));
        bf16_t* base = O + (size_t)u.pm * BM * ldc + u.pn * BM; const PG8_LAS float* sb = rst + u.ord * 256;
        const unsigned r0 = wr * 64 + fr, c0 = wc * 32 + 8 * fq;
#pragma unroll
        for (int ai = 0; ai < 2; ++ai)
#pragma unroll
            for (int m = 0; m < 4; ++m) {
                const unsigned row = r0 + ai * HALF + m * 16;
                const float rs = sb[row];
#pragma unroll
                for (int bj = 0; bj < 2; ++bj) {
                    f32x4 v0 = acc[ai][bj][m][0] * rs, v1 = acc[ai][bj][m][1] * rs;
                    if (ACT == 1) { f32x2 a = gelu_pk((f32x2){v0[0], v0[1]}), b = gelu_pk((f32x2){v0[2], v0[3]}), c = gelu_pk((f32x2){v1[0], v1[1]}), d = gelu_pk((f32x2){v1[2], v1[3]});
                        v0 = (f32x4){a.x, a.y, b.x, b.y}; v1 = (f32x4){c.x, c.y, d.x, d.y}; }
                    else {
#pragma unroll
                        for (int e = 0; e < 4; ++e) { const float a = fmaxf(v0[e], 0.f), b = fmaxf(v1[e], 0.f); v0[e] = a * a; v1[e] = b * b; } }
                    *(u32x4*)(base + row * (unsigned)ldc + c0 + bj * HALF) = pack8(v0, v1);
                }
                asm volatile("" ::: "memory");
            }
    }
};

template <int ACT> struct EpiT {
    static constexpr bool PERM = true, AFTER_DRAIN = false, IDEMP = true;
    const PG8_LAS float* rst; bf16_t* O; int nch; float* s1; float* s2;
    __device__ __forceinline__ void operator()(const f32x4 (&acc)[2][2][4][2], const Unit& u, int wr, int wc, int fr, int fq) const {
        asm volatile("" : "+v"(fr), "+v"(fq));
        const int tb = u.pn * BM + wc * 32 + 8 * fq;
        f32x4 rs[2][2];
#pragma unroll
        for (int bj = 0; bj < 2; ++bj)
#pragma unroll
            for (int n = 0; n < 2; ++n) rs[bj][n] = *(const PG8_LAS f32x4*)(rst + u.ord * 256 + wc * 32 + 8 * fq + bj * HALF + 4 * n);
        bf16_t* ob = O + ((size_t)(u.pn * 2) * nch + u.pm * BM) * 128 + wc * 32 + 8 * fq;
        f32x4 a1[2][2], a2[2][2];
#pragma unroll
        for (int bj = 0; bj < 2; ++bj)
#pragma unroll
            for (int n = 0; n < 2; ++n) { a1[bj][n] = (f32x4){0.f, 0.f, 0.f, 0.f}; a2[bj][n] = (f32x4){0.f, 0.f, 0.f, 0.f}; }
#pragma unroll
        for (int ai = 0; ai < 2; ++ai)
#pragma unroll
            for (int m = 0; m < 4; ++m) {
                const unsigned row = ai * HALF + wr * 64 + m * 16 + fr;
#pragma unroll
                for (int bj = 0; bj < 2; ++bj) {
                    f32x4 v0 = acc[ai][bj][m][0] * rs[bj][0], v1 = acc[ai][bj][m][1] * rs[bj][1];
                    if (ACT == 1) { f32x2 a = gelu_pk((f32x2){v0[0], v0[1]}), b = gelu_pk((f32x2){v0[2], v0[3]}), c = gelu_pk((f32x2){v1[0], v1[1]}), d = gelu_pk((f32x2){v1[2], v1[3]});
                        v0 = (f32x4){a.x, a.y, b.x, b.y}; v1 = (f32x4){c.x, c.y, d.x, d.y};
                        a1[bj][0] += v0; a1[bj][1] += v1; a2[bj][0] += v0 * v0; a2[bj][1] += v1 * v1; }
                    *(u32x4*)(ob + ((unsigned)bj * (unsigned)nch + row) * 128u) = pack8(v0, v1);
                }
                asm volatile("" ::: "memory");
            }
        if (ACT == 1) {
#pragma unroll
            for (int bj = 0; bj < 2; ++bj)
#pragma unroll
                for (int n = 0; n < 2; ++n)
#pragma unroll
                    for (int e = 0; e < 4; ++e) {
                        float x = a1[bj][n][e], y = a2[bj][n][e];
#pragma unroll
                        for (int o = 1; o < 16; o <<= 1) { x += __shfl_xor(x, o); y += __shfl_xor(y, o); }
                        if (fr == 0) { const size_t sl = (size_t)(tb + bj * HALF + 4 * n + e) * 24 + u.pm * 2 + wr; s1[sl] = x; s2[sl] = y; }
                    }
        }
    }
};

struct EpiRes {
    static constexpr bool PERM = true, AFTER_DRAIN = false, IDEMP = false;
    bf16_t* XB; float* ssq_next;
    __device__ __forceinline__ void operator()(const f32x4 (&acc)[2][2][4][2], const Unit& u, int wr, int wc, int fr, int fq) const {
        asm volatile("" : "+v"(fr), "+v"(fq));
        const int cb = u.pn * BM + wc * 32 + 8 * fq;
#pragma unroll
        for (int ai = 0; ai < 2; ++ai)
#pragma unroll
            for (int m = 0; m < 4; ++m) {
                const size_t row = (size_t)u.pm * BM + ai * HALF + wr * 64 + m * 16 + fr;
                float part = 0.f;
#pragma unroll
                for (int bj = 0; bj < 2; ++bj) {
                    const size_t off = row * 1024 + cb + bj * HALF;
                    const u32x4 xo = *(const u32x4*)(XB + off);
                    f32x4 x0, x1;
                    x0[0] = __uint_as_float(xo.x << 16); x0[1] = __uint_as_float(xo.x & 0xffff0000u); x0[2] = __uint_as_float(xo.y << 16); x0[3] = __uint_as_float(xo.y & 0xffff0000u);
                    x1[0] = __uint_as_float(xo.z << 16); x1[1] = __uint_as_float(xo.z & 0xffff0000u); x1[2] = __uint_as_float(xo.w << 16); x1[3] = __uint_as_float(xo.w & 0xffff0000u);
                    x0 += acc[ai][bj][m][0]; x1 += acc[ai][bj][m][1];
                    const u32x4 w = pack8(x0, x1);
                    *(u32x4*)(XB + off) = w;
                    x0[0] = __uint_as_float(w.x << 16); x0[1] = __uint_as_float(w.x & 0xffff0000u); x0[2] = __uint_as_float(w.y << 16); x0[3] = __uint_as_float(w.y & 0xffff0000u);
                    x1[0] = __uint_as_float(w.z << 16); x1[1] = __uint_as_float(w.z & 0xffff0000u); x1[2] = __uint_as_float(w.w << 16); x1[3] = __uint_as_float(w.w & 0xffff0000u);
                    part += ((x0[0] * x0[0] + x0[1] * x0[1]) + (x0[2] * x0[2] + x0[3] * x0[3])) + ((x1[0] * x1[0] + x1[1] * x1[1]) + (x1[2] * x1[2] + x1[3] * x1[3]));
                }
                part += __shfl_xor(part, 16); part += __shfl_xor(part, 32);
                if (fq == 0) ssq_next[row * 16 + u.pn * 4 + wc] = part;
            }
    }
};

template <class Epi, class Sched, bool ALIGN_EPI = false, bool SP2 = false>
__device__ __forceinline__ void gemm_phase(PG8_LAS unsigned char* lds, const Gemm g, const Sched& S, const Epi& E) {
    int tid_ = threadIdx.x; asm volatile("" : "+v"(tid_), "+s"(lds));
    const int tid = tid_, wid = __builtin_amdgcn_readfirstlane(tid >> 6), lane = tid & 63, wr = wid >> 2, wc = wid & 3, fr = lane & 15, fq = lane >> 4;
    const bf16_t* gA = g.A; const bf16_t* gBt = g.Bt; asm volatile("" : "+s"(gA), "+s"(gBt));
    const int K = g.K, nt = K / BK;
    unsigned voffA[2], voffB[2];
#pragma unroll
    for (int i = 0; i < 2; ++i) { int R, C; stage_rc(tid * 16 + i * 8192, R, C); const int Rb = Epi::PERM ? ((R & ~31) + perm32(R & 31)) : R;
        voffA[i] = (unsigned)(R * K + C) * 2u; voffB[i] = (unsigned)(Rb * K + C) * 2u; }
    const size_t kstep = (size_t)(BK * 2);
    const size_t hstep = (size_t)HALF * K * 2;
    const size_t tstep = 2 * hstep;
    const unsigned ldsw = (unsigned)wid * 1024u;
    const int aoff = lds_byte(wr * 64 + fr, fq * 8), boff = lds_byte(wc * 32 + fr, fq * 8);
#define PG8_SA(b, h) (((b) * 2 + (h)) * HTB)
#define PG8_SB(b, h) ((4 + (b) * 2 + (h)) * HTB)
#define PG8_STAGE(bufoff, gbase, voff) do { _Pragma("unroll") for (int _i = 0; _i < 2; ++_i) \
        __builtin_amdgcn_global_load_lds((const unsigned*)((const char*)(gbase) + (voff)[_i]), (PG8_LAS unsigned*)(lds + (bufoff) + ldsw + _i * 8192), 16, 0, 0); } while (0)
#define PG8_LDA(dst, b, h) do { _Pragma("unroll") for (int m = 0; m < 4; ++m) _Pragma("unroll") for (int k = 0; k < 2; ++k) dst[m][k] = *(const PG8_LAS bf16x8*)(lds + PG8_SA(b, h) + aoff + m * 2048 + k * 1024); } while (0)
#define PG8_LDB(dst, b, h) do { _Pragma("unroll") for (int n = 0; n < 2; ++n) _Pragma("unroll") for (int k = 0; k < 2; ++k) dst[n][k] = *(const PG8_LAS bf16x8*)(lds + PG8_SB(b, h) + boff + n * 2048 + k * 1024); } while (0)
#define PG8_MMA(ai, bj, At, Bt) do { __builtin_amdgcn_s_setprio(1); _Pragma("unroll") for (int m = 0; m < 4; ++m) _Pragma("unroll") for (int n = 0; n < 2; ++n) _Pragma("unroll") for (int k = 0; k < 2; ++k) \
        acc[ai][bj][m][n] = __builtin_amdgcn_mfma_f32_16x16x32_bf16(Bt[n][k], At[m][k], acc[ai][bj][m][n], 0, 0, 0); __builtin_amdgcn_s_setprio(0); } while (0)
#define PG8_WAIT_V(n) asm volatile("s_waitcnt vmcnt(" #n ")" ::: "memory")
#define PG8_WAIT_L(n) asm volatile("s_waitcnt lgkmcnt(" #n ")" ::: "memory")
#define PG8_BAR __builtin_amdgcn_s_barrier()
#define PG8_SCHED __builtin_amdgcn_sched_barrier(0)
    Unit cur, nxt; int ui = 0;
    if (!S.next(0, cur)) return;
    f32x4 acc[2][2][4][2];
#pragma unroll
    for (int a = 0; a < 2; ++a)
#pragma unroll
        for (int b = 0; b < 2; ++b)
#pragma unroll
            for (int m = 0; m < 4; ++m)
#pragma unroll
                for (int n = 0; n < 2; ++n) acc[a][b][m][n] = (f32x4){0.f, 0.f, 0.f, 0.f};
    bf16x8 At[4][2], B0[2][2], B1[2][2];
    const char* cA = (const char*)gA + (size_t)cur.pm * tstep; const char* cB = (const char*)gBt + (size_t)cur.pn * tstep;
    S.a_ready(cur);
    if constexpr (SP2) {
        PG8_STAGE(PG8_SB(0, 0), cB, voffB); PG8_STAGE(PG8_SB(0, 1), cB + hstep, voffB); PG8_STAGE(PG8_SA(0, 0), cA, voffA); PG8_STAGE(PG8_SA(0, 1), cA + hstep, voffA);
        if (wr == 1) PG8_BAR;
        PG8_WAIT_V(2); PG8_BAR;
        PG8_STAGE(PG8_SB(1, 0), cB + kstep, voffB); PG8_STAGE(PG8_SA(1, 0), cA + kstep, voffA); PG8_STAGE(PG8_SB(1, 1), cB + hstep + kstep, voffB);
        PG8_WAIT_V(6); PG8_BAR;
    } else {
        PG8_STAGE(PG8_SB(0, 0), cB, voffB); PG8_STAGE(PG8_SA(0, 0), cA, voffA); PG8_STAGE(PG8_SB(0, 1), cB + hstep, voffB); PG8_STAGE(PG8_SA(0, 1), cA + hstep, voffA);
        if (wr == 1) PG8_BAR;
        PG8_WAIT_V(4); PG8_BAR;
        PG8_STAGE(PG8_SB(1, 0), cB + kstep, voffB); PG8_STAGE(PG8_SA(1, 0), cA + kstep, voffA); PG8_STAGE(PG8_SB(1, 1), cB + hstep + kstep, voffB);
        PG8_WAIT_V(6); PG8_BAR;
    }
    for (;;) {
        const bool has_next = S.next(ui + 1, nxt);
        const char* nA = has_next ? (const char*)gA + (size_t)nxt.pm * tstep : cA; const char* nB = has_next ? (const char*)gBt + (size_t)nxt.pn * tstep : cB;
        for (int t = 0; t < nt; t += 2) {
            const bool last = (t == nt - 2);
            const char* a1 = cA + (size_t)(t + 1) * kstep;
            const char* a2 = last ? nA : cA + (size_t)(t + 2) * kstep; const char* b2 = last ? nB : cB + (size_t)(t + 2) * kstep;
            const char* a3 = a2 + kstep; const char* b3 = b2 + kstep;
            if (last && has_next) S.a_ready(nxt);
            if constexpr (SP2) {
            PG8_LDB(B0, 0, 0); PG8_LDB(B1, 0, 1); PG8_SCHED; PG8_LDA(At, 0, 0); PG8_STAGE(PG8_SA(1, 1), a1 + hstep, voffA);
            PG8_WAIT_V(8); PG8_WAIT_L(0); PG8_BAR; PG8_MMA(0, 0, At, B0); PG8_MMA(0, 1, At, B1); PG8_BAR; PG8_SCHED;
            PG8_LDA(At, 0, 1); PG8_STAGE(PG8_SB(0, 0), b2, voffB); PG8_STAGE(PG8_SB(0, 1), b2 + hstep, voffB); PG8_STAGE(PG8_SA(0, 0), a2, voffA);
            PG8_WAIT_V(8); PG8_WAIT_L(0); PG8_BAR; PG8_MMA(1, 0, At, B0); PG8_MMA(1, 1, At, B1); PG8_BAR; PG8_SCHED;
            PG8_LDB(B0, 1, 0); PG8_LDB(B1, 1, 1); PG8_SCHED; PG8_LDA(At, 1, 0); PG8_STAGE(PG8_SA(0, 1), a2 + hstep, voffA);
            PG8_WAIT_V(8); PG8_WAIT_L(0); PG8_BAR; PG8_MMA(0, 0, At, B0); PG8_MMA(0, 1, At, B1); PG8_BAR; PG8_SCHED;
            PG8_LDA(At, 1, 1); PG8_STAGE(PG8_SB(1, 0), b3, voffB); PG8_STAGE(PG8_SB(1, 1), b3 + hstep, voffB); PG8_STAGE(PG8_SA(1, 0), a3, voffA);
            PG8_WAIT_V(8); PG8_WAIT_L(0); PG8_BAR; PG8_MMA(1, 0, At, B0); PG8_MMA(1, 1, At, B1); PG8_BAR; PG8_SCHED;
            } else {
            PG8_LDB(B0, 0, 0); PG8_SCHED; PG8_LDA(At, 0, 0); PG8_STAGE(PG8_SA(1, 1), a1 + hstep, voffA);
            PG8_WAIT_L(8); PG8_BAR; PG8_WAIT_L(0); PG8_MMA(0, 0, At, B0); PG8_BAR; PG8_SCHED;
            PG8_LDB(B1, 0, 1); PG8_STAGE(PG8_SB(0, 0), b2, voffB);
            PG8_BAR; PG8_WAIT_L(0); PG8_MMA(0, 1, At, B1); PG8_BAR;
            PG8_LDA(At, 0, 1); PG8_STAGE(PG8_SA(0, 0), a2, voffA);
            PG8_BAR; PG8_WAIT_L(0); PG8_MMA(1, 0, At, B0); PG8_BAR; PG8_SCHED;
            PG8_STAGE(PG8_SB(0, 1), b2 + hstep, voffB);
            PG8_WAIT_V(6); PG8_BAR; PG8_MMA(1, 1, At, B1); PG8_BAR;
            PG8_LDB(B0, 1, 0); PG8_SCHED; PG8_LDA(At, 1, 0); PG8_STAGE(PG8_SA(0, 1), a2 + hstep, voffA);
            PG8_WAIT_L(8); PG8_BAR; PG8_WAIT_L(0); PG8_MMA(0, 0, At, B0); PG8_BAR; PG8_SCHED;
            PG8_LDB(B1, 1, 1); PG8_STAGE(PG8_SB(1, 0), b3, voffB);
            PG8_BAR; PG8_WAIT_L(0); PG8_MMA(0, 1, At, B1); PG8_BAR;
            PG8_LDA(At, 1, 1); PG8_STAGE(PG8_SA(1, 0), a3, voffA);
            PG8_BAR; PG8_WAIT_L(0); PG8_MMA(1, 0, At, B0); PG8_BAR; PG8_SCHED;
            PG8_STAGE(PG8_SB(1, 1), b3 + hstep, voffB);
            PG8_WAIT_V(6); PG8_BAR; PG8_MMA(1, 1, At, B1); PG8_BAR;
            }
        }
        if constexpr (ALIGN_EPI) { if (wr == 0) PG8_BAR; }
        if constexpr (!Epi::AFTER_DRAIN) { E(acc, cur, wr, wc, fr, fq);
#if defined(PROBE) && (PROBE & 128)
            if constexpr (Epi::IDEMP) E(acc, cur, wr, wc, fr, fq);
#endif
            S.done(cur); }
        if (!has_next) break;
#pragma unroll
        for (int a = 0; a < 2; ++a)
#pragma unroll
            for (int b = 0; b < 2; ++b)
#pragma unroll
                for (int m = 0; m < 4; ++m)
#pragma unroll
                    for (int n = 0; n < 2; ++n) acc[a][b][m][n] = (f32x4){0.f, 0.f, 0.f, 0.f};
        cur = nxt; cA = nA; cB = nB; ++ui;
        if constexpr (ALIGN_EPI) { if (wr == 1) PG8_BAR; }
    }
    PG8_WAIT_V(0);
    if constexpr (!ALIGN_EPI) { if (wr == 0) PG8_BAR; }
    PG8_BAR;
    if constexpr (Epi::AFTER_DRAIN) { E.fused(acc, cur, wr, wc, fr, fq, lds, wid, lane); S.done(cur); }
#undef PG8_SA
#undef PG8_SB
#undef PG8_STAGE
#undef PG8_LDA
#undef PG8_LDB
#undef PG8_MMA
#undef PG8_WAIT_V
#undef PG8_WAIT_L
#undef PG8_BAR
#undef PG8_SCHED
}
}

#define LAS __attribute__((address_space(3)))
using pg8::bf16_t; using pg8::bf16x8; using pg8::f32x4; using pg8::u32x4; using pg8::u32x2; using pg8::f32x2;
constexpr int M = 16384, D = 1024, SEQ = 4096;
constexpr int NWAVES = 8, NTHREADS = 512;
constexpr int LDS_BYTES = 147456;
constexpr size_t MiB = 1u << 20;
constexpr size_t WS_STAT = 0, OFF_LB = 0;
constexpr size_t WS_WA = 1 * MiB, WS_WB = 7 * MiB, WS_WO = 13 * MiB, WS_W1 = 19 * MiB, WS_W2 = 27 * MiB;
constexpr size_t WS_XB = 35 * MiB;
constexpr size_t WS_ACT = 67 * MiB;
constexpr size_t WS_QAB = WS_ACT, WS_KA = WS_ACT + 32 * MiB, WS_GA = WS_ACT + 48 * MiB, WS_KB = WS_ACT + 64 * MiB, WS_VB = WS_ACT + 80 * MiB, WS_LF = WS_ACT + 96 * MiB, WS_IAT = WS_ACT + 128 * MiB;
constexpr size_t WS_ST = WS_ACT + 160 * MiB;
constexpr size_t WS_H = WS_ACT;
constexpr size_t WS_U = WS_ACT, WS_VT = WS_ACT + 96 * MiB;
constexpr size_t WS_SSQ = WS_VT + 96 * MiB;
constexpr size_t WS_LNP = WS_SSQ + 9 * MiB;
constexpr size_t LNP_STRIDE = (size_t)M * 24 * 4;
constexpr size_t WS_END = WS_LNP + 6 * MiB;

__device__ __forceinline__ unsigned f2bf(float f) { unsigned u = __float_as_uint(f); return (u + 0x7fffu + ((u >> 16) & 1u)) >> 16; }
__device__ __forceinline__ unsigned pk2(float lo, float hi) { return f2bf(lo) | (f2bf(hi) << 16); }
__device__ __forceinline__ float bflo(unsigned u) { return __uint_as_float(u << 16); }
__device__ __forceinline__ float bfhi(unsigned u) { return __uint_as_float(u & 0xffff0000u); }
__device__ __forceinline__ float wave_sum(float v) {
#pragma unroll
    for (int o = 1; o < 64; o <<= 1) v += __shfl_xor(v, o);
    return v;
}

struct Params { const float* in[16]; float* out; unsigned char* ws; int ph_lo, ph_hi; };
enum { I_X = 0, I_MIXN, I_MLPN, I_W1, I_W2, I_ABIN, I_ABOUT, I_LBL, I_HON, I_GMIN, I_LNG, I_LNB, I_GMWS, I_GMBS, I_GMOUT, I_FN };

__device__ __forceinline__ void conv_seg(const float* W, int ldw, int col0, int ncols, int K, const float* gain, bf16_t* WT, int row_off, LAS float* scr, int gw, int ngw, int lane) {
    const int nblk = ncols / 32, nitems = (K / 64) * nblk;
    int it = gw; if (it >= nitems) return;
    const int k8 = lane >> 3, n4 = lane & 7;
    f32x4 cur[8];
    { const int kb = it / nblk, nb = it % nblk; const float* src = W + (size_t)(64 * kb + k8) * ldw + col0 + 32 * nb + 4 * n4;
#pragma unroll
      for (int i = 0; i < 8; ++i) cur[i] = *(const f32x4*)(src + (size_t)(8 * i) * ldw); }
    for (;;) {
        const int nx = it + ngw; const bool has = nx < nitems;
        f32x4 nxt[8];
        if (has) { const int kb = nx / nblk, nb = nx % nblk; const float* src = W + (size_t)(64 * kb + k8) * ldw + col0 + 32 * nb + 4 * n4;
#pragma unroll
            for (int i = 0; i < 8; ++i) nxt[i] = *(const f32x4*)(src + (size_t)(8 * i) * ldw); }
        const int kb = it / nblk, nb = it % nblk, k0 = 64 * kb, n0 = 32 * nb;
#pragma unroll
        for (int i = 0; i < 8; ++i) { LAS float* d = scr + (8 * i + k8) * 33 + 4 * n4; d[0] = cur[i][0]; d[1] = cur[i][1]; d[2] = cur[i][2]; d[3] = cur[i][3]; }
        asm volatile("s_waitcnt lgkmcnt(0)" ::: "memory");
        const int c = lane & 7;
        f32x4 g0 = (f32x4){1.f, 1.f, 1.f, 1.f}, g1 = g0;
        if (gain) { g0 = *(const f32x4*)(gain + k0 + 8 * c); g1 = *(const f32x4*)(gain + k0 + 8 * c + 4); }
#pragma unroll
        for (int j = 0; j < 4; ++j) { const int n = (lane >> 3) + 8 * j; const LAS float* s = scr + (8 * c) * 33 + n;
            u32x4 o; o.x = pg8::cvt_pk_bf16(s[0 * 33] * g0[0], s[1 * 33] * g0[1]); o.y = pg8::cvt_pk_bf16(s[2 * 33] * g0[2], s[3 * 33] * g0[3]); o.z = pg8::cvt_pk_bf16(s[4 * 33] * g1[0], s[5 * 33] * g1[1]); o.w = pg8::cvt_pk_bf16(s[6 * 33] * g1[2], s[7 * 33] * g1[3]);
            *(u32x4*)(WT + (size_t)(row_off + n0 + n) * K + k0 + 8 * c) = o; }
        asm volatile("s_waitcnt lgkmcnt(0)" ::: "memory");
        if (!has) break;
#pragma unroll
        for (int i = 0; i < 8; ++i) cur[i] = nxt[i];
        it = nx;
    }
}

__device__ __forceinline__ void conv_chore(const Params& p, int layer, int what, LAS unsigned char* lds, int gw, int ngw, int wave, int lane) {
    if (layer > 3) return;
    LAS float* scr = (LAS float*)(lds + wave * 16384);
    unsigned char* ws = p.ws;
    bf16_t* WA = (bf16_t*)(ws + WS_WA); bf16_t* WB = (bf16_t*)(ws + WS_WB); bf16_t* WO = (bf16_t*)(ws + WS_WO); bf16_t* W1 = (bf16_t*)(ws + WS_W1); bf16_t* W2 = (bf16_t*)(ws + WS_W2);
    const float* gmix = p.in[I_MIXN] + layer * 1024; const float* gmlp = p.in[I_MLPN] + layer * 1024;
    const int e = layer >> 1;
    if ((layer & 1) == 0) {
        const float* Win = p.in[I_ABIN] + (size_t)e * 1024 * 3584;
        if (what & 1) {
            const int src[5] = {0, 512, 2048, 2560, 1536};
#pragma unroll
            for (int s = 0; s < 5; ++s) conv_seg(Win, 3584, src[s], 512, 1024, gmix, WA, 512 * s, scr, gw, ngw, lane);
            conv_seg(Win, 3584, 1024, 512, 1024, gmix, WB, 0, scr, gw, ngw, lane);
            conv_seg(Win, 3584, 3072, 512, 1024, gmix, WB, 512, scr, gw, ngw, lane);
        }
        if (what & 2) conv_seg(p.in[I_ABOUT] + (size_t)e * 1024 * 1024, 1024, 0, 1024, 1024, nullptr, WO, 0, scr, gw, ngw, lane);
    } else {
        const float* Win = p.in[I_GMIN] + (size_t)e * 1024 * 6144;
        if (what & 1) { conv_seg(Win, 6144, 0, 3072, 1024, gmix, WA, 0, scr, gw, ngw, lane);
                        conv_seg(Win, 6144, 3072, 3072, 1024, gmix, WB, 0, scr, gw, ngw, lane); }
        if (what & 2) conv_seg(p.in[I_GMOUT] + (size_t)e * 3072 * 1024, 1024, 0, 1024, 3072, nullptr, WO, 0, scr, gw, ngw, lane);
    }
    if (what & 4) conv_seg(p.in[I_W1] + (size_t)layer * 1024 * 4096, 4096, 0, 4096, 1024, gmlp, W1, 0, scr, gw, ngw, lane);
    if (what & 8) conv_seg(p.in[I_W2] + (size_t)layer * 4096 * 1024, 1024, 0, 1024, 4096, nullptr, W2, 0, scr, gw, ngw, lane);
}

__device__ __forceinline__ bf16x8 frag2(const u32x2 lo, const u32x2 hi) { return __builtin_bit_cast(bf16x8, (u32x4){lo.x, lo.y, hi.x, hi.y}); }
__device__ __forceinline__ u32x2 pack4(const f32x4 v) { u32x2 r; r.x = pk2(v[0], v[1]); r.y = pk2(v[2], v[3]); return r; }
constexpr size_t OFF_DEC = 65536;
template <bool OUT>
__device__ __forceinline__ void hgrn_unit(const Params& p, int unit, LAS unsigned char* lds, int tid, int wave, int lane, bool dummy = false) {
    unsigned char* ws = p.ws;
    const float* LF = (const float*)(ws + WS_LF); const bf16_t* KA = (const bf16_t*)(ws + WS_KA); bf16_t* QAB = (bf16_t*)(ws + WS_QAB); const bf16_t* GA = (const bf16_t*)(ws + WS_GA);
    const bf16_t* IAT = (const bf16_t*)(ws + WS_IAT); float* ST = (float*)(ws + WS_ST); float* DEC = (float*)(ws + OFF_DEC);
    const int bh = unit >> 4, jp = unit & 15, b = bh >> 2, h = bh & 3;
    constexpr int PC = 272, PT = 272;
    LAS unsigned char* Qs = lds; LAS unsigned char* Ks = lds + 128 * PC; LAS unsigned char* KhT = lds + 256 * PC; LAS unsigned char* VTs = KhT + 128 * PT;
    LAS float* DECs = (LAS float*)(VTs + 128 * PT); LAS float* SSQs = DECs + 512;
    const int fr = lane & 15, fq = lane >> 4;
    f32x4 S[8];
    float* stp = ST + ((size_t)unit * 128 + 16 * wave + fr) * 128 + 4 * fq;
#pragma unroll
    for (int dt = 0; dt < 8; ++dt) S[dt] = OUT ? *(const f32x4*)(stp + 16 * dt) : (f32x4){0.f, 0.f, 0.f, 0.f};
    float dprod = 1.f;
    for (int sub = 0; sub < 2; ++sub) {
    const size_t row0 = (size_t)b * SEQ + 128 * (2 * jp + sub);
    f32x4 oacc[4][2];
    __syncthreads();
    {
        u32x4 vt[4];
#pragma unroll
        for (int i = 0; i < 4; ++i) { const int idx = tid + NTHREADS * i; vt[i] = *(const u32x4*)(IAT + ((row0 >> 7) * 1024 + h * 128 + (idx >> 4)) * 128 + (idx & 15) * 8); }
        const int tg = tid & 7, d8 = (tid >> 3) & 15, c = tid >> 7;
        const size_t r0 = row0 + 32 * c + 4 * tg;
        const int ch0 = h * 128 + 8 * d8;
        f32x4 la[4], lb4[4]; u32x4 kr[4], qr[4];
#pragma unroll
        for (int i = 0; i < 4; ++i) { la[i] = *(const f32x4*)(LF + (r0 + i) * 512 + ch0); lb4[i] = *(const f32x4*)(LF + (r0 + i) * 512 + ch0 + 4); kr[i] = *(const u32x4*)(KA + (r0 + i) * 512 + ch0);
            if (OUT) qr[i] = *(const u32x4*)(QAB + (r0 + i) * 1024 + ch0); }
        float bcum[4][8];
#pragma unroll
        for (int e = 0; e < 8; ++e) { float run = 0.f;
#pragma unroll
            for (int i = 0; i < 4; ++i) { run += (e < 4) ? la[i][e & 3] : lb4[i][e & 3]; bcum[i][e] = run; } }
        float excl[8], tot[8];
#pragma unroll
        for (int e = 0; e < 8; ++e) { const float loc = bcum[3][e]; float inc = loc;
#pragma unroll
            for (int o = 1; o < 8; o <<= 1) { const float y = __shfl_up(inc, o, 8); if (tg >= o) inc += y; }
            excl[e] = inc - loc; tot[e] = __shfl(inc, 7, 8); }
        if (tg == 0) { *(LAS f32x4*)(DECs + c * 128 + 8 * d8) = (f32x4){__expf(tot[0]), __expf(tot[1]), __expf(tot[2]), __expf(tot[3])};
                       *(LAS f32x4*)(DECs + c * 128 + 8 * d8 + 4) = (f32x4){__expf(tot[4]), __expf(tot[5]), __expf(tot[6]), __expf(tot[7])}; }
        unsigned khb[4][8];
#pragma unroll
        for (int i = 0; i < 4; ++i) {
            unsigned qw[4], kw[4];
#pragma unroll
            for (int e2 = 0; e2 < 4; ++e2) {
                const float b0 = excl[2 * e2] + bcum[i][2 * e2], b1 = excl[2 * e2 + 1] + bcum[i][2 * e2 + 1];
                const float k0 = bflo(kr[i][e2]), k1 = bfhi(kr[i][e2]);
                khb[i][2 * e2] = f2bf(k0 * __expf(tot[2 * e2] - b0)); khb[i][2 * e2 + 1] = f2bf(k1 * __expf(tot[2 * e2 + 1] - b1));
                if (OUT) { qw[e2] = pk2(bflo(qr[i][e2]) * __expf(b0), bfhi(qr[i][e2]) * __expf(b1)); kw[e2] = pk2(k0 * __expf(-b0), k1 * __expf(-b1)); }
            }
            if (OUT) { *(LAS u32x4*)(Qs + (32 * c + 4 * tg + i) * PC + 16 * d8) = (u32x4){qw[0], qw[1], qw[2], qw[3]};
                       *(LAS u32x4*)(Ks + (32 * c + 4 * tg + i) * PC + 16 * d8) = (u32x4){kw[0], kw[1], kw[2], kw[3]}; }
        }
#pragma unroll
        for (int e = 0; e < 8; ++e) *(LAS u32x2*)(KhT + (8 * d8 + e) * PT + (32 * c + 4 * tg) * 2) = (u32x2){khb[0][e] | (khb[1][e] << 16), khb[2][e] | (khb[3][e] << 16)};
#pragma unroll
        for (int i = 0; i < 4; ++i) { const int idx = tid + NTHREADS * i; *(LAS u32x4*)(VTs + (idx >> 4) * PT + (idx & 15) * 16) = vt[i]; }
    }
    __syncthreads();
#pragma unroll
    for (int cc = 0; cc < 4; ++cc) {
        {
            const int tb = 32 * cc;
            if (OUT) {
                f32x4 s00 = (f32x4){0.f, 0.f, 0.f, 0.f}, s01 = s00, s11 = s00;
#pragma unroll
                for (int kk = 0; kk < 4; ++kk) {
                    const bf16x8 kf0 = *(const LAS bf16x8*)(Ks + (tb + fr) * PC + (32 * kk + 8 * fq) * 2), kf1 = *(const LAS bf16x8*)(Ks + (tb + 16 + fr) * PC + (32 * kk + 8 * fq) * 2);
                    const bf16x8 qf0 = *(const LAS bf16x8*)(Qs + (tb + fr) * PC + (32 * kk + 8 * fq) * 2), qf1 = *(const LAS bf16x8*)(Qs + (tb + 16 + fr) * PC + (32 * kk + 8 * fq) * 2);
                    s00 = __builtin_amdgcn_mfma_f32_16x16x32_bf16(kf0, qf0, s00, 0, 0, 0);
                    s01 = __builtin_amdgcn_mfma_f32_16x16x32_bf16(kf0, qf1, s01, 0, 0, 0);
                    s11 = __builtin_amdgcn_mfma_f32_16x16x32_bf16(kf1, qf1, s11, 0, 0, 0);
                }
#pragma unroll
                for (int e = 0; e < 4; ++e) { const bool keep = (4 * fq + e) <= fr; s00[e] = keep ? s00[e] : 0.f; s11[e] = keep ? s11[e] : 0.f; }
                const bf16x8 pf0 = frag2(pack4(s00), (u32x2){0u, 0u}), pf1 = frag2(pack4(s01), pack4(s11));
                const bf16x8 vf = frag2(*(const LAS u32x2*)(VTs + (16 * wave + fr) * PT + (tb + 4 * fq) * 2), *(const LAS u32x2*)(VTs + (16 * wave + fr) * PT + (tb + 16 + 4 * fq) * 2));
                f32x4 o0 = __builtin_amdgcn_mfma_f32_16x16x32_bf16(vf, pf0, (f32x4){0.f, 0.f, 0.f, 0.f}, 0, 0, 0);
                f32x4 o1 = __builtin_amdgcn_mfma_f32_16x16x32_bf16(vf, pf1, (f32x4){0.f, 0.f, 0.f, 0.f}, 0, 0, 0);
#pragma unroll
                for (int kk = 0; kk < 4; ++kk) {
                    const bf16x8 sf = frag2(pack4(S[2 * kk]), pack4(S[2 * kk + 1]));
                    const bf16x8 q0 = frag2(*(const LAS u32x2*)(Qs + (tb + fr) * PC + (32 * kk + 4 * fq) * 2), *(const LAS u32x2*)(Qs + (tb + fr) * PC + (32 * kk + 16 + 4 * fq) * 2));
                    const bf16x8 q1 = frag2(*(const LAS u32x2*)(Qs + (tb + 16 + fr) * PC + (32 * kk + 4 * fq) * 2), *(const LAS u32x2*)(Qs + (tb + 16 + fr) * PC + (32 * kk + 16 + 4 * fq) * 2));
                    o0 = __builtin_amdgcn_mfma_f32_16x16x32_bf16(sf, q0, o0, 0, 0, 0);
                    o1 = __builtin_amdgcn_mfma_f32_16x16x32_bf16(sf, q1, o1, 0, 0, 0);
                }
                oacc[cc][0] = o0; oacc[cc][1] = o1;
            }
            const bf16x8 vb = *(const LAS bf16x8*)(VTs + (16 * wave + fr) * PT + (tb + 8 * fq) * 2);
#pragma unroll
            for (int dt = 0; dt < 8; ++dt) {
                const f32x4 dc = *(const LAS f32x4*)(DECs + cc * 128 + 16 * dt + 4 * fq);
                const bf16x8 kf = *(const LAS bf16x8*)(KhT + (16 * dt + fr) * PT + (tb + 8 * fq) * 2);
                S[dt] = __builtin_amdgcn_mfma_f32_16x16x32_bf16(kf, vb, S[dt] * dc, 0, 0, 0);
            }
        }
    }
    if (OUT) {
#pragma unroll
        for (int cc = 0; cc < 4; ++cc)
#pragma unroll
            for (int tt = 0; tt < 2; ++tt) { const f32x4 o = oacc[cc][tt]; float v = (o[0] * o[0] + o[1] * o[1]) + (o[2] * o[2] + o[3] * o[3]);
                v += __shfl_xor(v, 16); v += __shfl_xor(v, 32); if (fq == 0) SSQs[(32 * cc + 16 * tt + fr) * 8 + wave] = v; }
        __syncthreads();
#pragma unroll
        for (int cc = 0; cc < 4; ++cc)
#pragma unroll
            for (int tt = 0; tt < 2; ++tt) { const int t = 32 * cc + 16 * tt + fr;
                const f32x4 a = *(const LAS f32x4*)(SSQs + t * 8), b4 = *(const LAS f32x4*)(SSQs + t * 8 + 4);
                const float r = __builtin_amdgcn_rsqf((((a[0] + a[1]) + (a[2] + a[3])) + ((b4[0] + b4[1]) + (b4[2] + b4[3]))) * (1.0f / 128.0f) + 1e-6f);
                const int col = h * 128 + 16 * wave + 4 * fq;
                const u32x2 g = *(const u32x2*)(GA + (row0 + t) * 512 + col); const f32x4 o = oacc[cc][tt];
                u32x2 w; w.x = pk2(o[0] * r * bflo(g.x), o[1] * r * bfhi(g.x)); w.y = pk2(o[2] * r * bflo(g.y), o[3] * r * bfhi(g.y));
                if (dummy) *(u32x2*)((bf16_t*)(ws + WS_VB) + (row0 + t) * 512 + col) = w; else *(u32x2*)(QAB + (row0 + t) * 1024 + col) = w; }
    } else {
        if (tid < 128) dprod *= (DECs[tid] * DECs[128 + tid]) * (DECs[256 + tid] * DECs[384 + tid]);
    }
    }
    if (!OUT) {
#pragma unroll
        for (int dt = 0; dt < 8; ++dt) *(f32x4*)(stp + 16 * dt) = S[dt];
        if (tid < 128) DEC[(size_t)unit * 128 + tid] = dprod;
    }
}
__device__ __forceinline__ void hgrn_scan(const Params& p, int gtid, int nthr) {
    float* ST = (float*)(p.ws + WS_ST); const float* DEC = (const float*)(p.ws + OFF_DEC);
    for (int i = gtid; i < 16 * 4096; i += nthr) {
        const int bh = i >> 12, q4 = i & 4095, d = (4 * q4) & 127;
        f32x4 run = (f32x4){0.f, 0.f, 0.f, 0.f};
#pragma unroll 8
        for (int j = 0; j < 16; ++j) { f32x4* ps = (f32x4*)(ST + (size_t)(bh * 16 + j) * 16384 + 4 * q4); const f32x4 L = *ps; const f32x4 dc = *(const f32x4*)(DEC + (size_t)(bh * 16 + j) * 128 + d);
            *ps = run; run = dc * run + L; }
    }
}
__device__ __forceinline__ void attn_unit(const Params& p, int unit, LAS unsigned char* lds, int tid, int wave, int lane, bool dummy = false) {
    unsigned char* ws = p.ws;
    bf16_t* QAB = (bf16_t*)(ws + WS_QAB); const bf16_t* KB = (const bf16_t*)(ws + WS_KB); const bf16_t* VBT = (const bf16_t*)(ws + WS_IAT) + (size_t)512 * 128;
    const int bh = unit >> 5, qb = unit & 31, b = bh >> 2, h = bh & 3;
    const size_t row0 = (size_t)b * SEQ;
    constexpr int PC = 272, PT = 144;
    constexpr int ABUF = 64 * PC + 128 * PT;
    LAS unsigned* FL = (LAS unsigned*)(lds + 2 * ABUF);
    const int fr = lane & 15, fq = lane >> 4;
    const int tq = 128 * qb + 16 * wave + fr;
    bf16x8 qf[4];
    { const bf16_t* qp = QAB + (row0 + tq) * 1024 + 512 + h * 128 + 8 * fq;
#pragma unroll
      for (int kk = 0; kk < 4; ++kk) qf[kk] = *(const bf16x8*)(qp + 32 * kk); }
    f32x4 O[8];
#pragma unroll
    for (int dt = 0; dt < 8; ++dt) O[dt] = (f32x4){0.f, 0.f, 0.f, 0.f};
    float R = 0.f; bool wdone = false;
    if (tid < 8) FL[tid] = 0u;
    u32x4 kreg[2], vreg[2];
#define ATT_LOAD(s0_) do { _Pragma("unroll") for (int i = 0; i < 2; ++i) { const int idx = tid + NTHREADS * i; \
        kreg[i] = *(const u32x4*)(KB + (row0 + (s0_) + (idx >> 4)) * 512 + h * 128 + (idx & 15) * 8); \
        vreg[i] = *(const u32x4*)(VBT + (((row0 + (s0_)) >> 7) * 1024 + h * 128 + (idx >> 3)) * 128 + ((s0_) & 127) + (idx & 7) * 8); } } while (0)
#define ATT_STORE(buf_) do { _Pragma("unroll") for (int i = 0; i < 2; ++i) { const int idx = tid + NTHREADS * i; \
        *(LAS u32x4*)(lds + (buf_) * ABUF + (idx >> 4) * PC + (idx & 15) * 16) = kreg[i]; \
        *(LAS u32x4*)(lds + (buf_) * ABUF + 64 * PC + (idx >> 3) * PT + (idx & 7) * 16) = vreg[i]; } } while (0)
    ATT_LOAD(64 * (2 * qb + 1));
    ATT_STORE(0);
    ATT_LOAD(64 * (2 * qb));
    __syncthreads();
    int cur = 0;
    for (int kt0 = 2 * qb + 1; kt0 >= 0; --kt0, cur ^= 1) {
        const int s0 = 64 * kt0;
        { unsigned all = 1u;
#pragma unroll
          for (int i = 0; i < 8; ++i) all &= FL[i];
          if (all) break; }
        if (kt0 > 0) { ATT_STORE(cur ^ 1); if (kt0 > 1) ATT_LOAD(s0 - 128); }
        LAS unsigned char* Ks = lds + cur * ABUF; LAS unsigned char* VTs = Ks + 64 * PC;
        if (s0 < 128 * qb + 16 * wave + 15 && !wdone) {
        f32x4 z[4];
#pragma unroll
        for (int kt = 0; kt < 4; ++kt) { z[kt] = (f32x4){0.f, 0.f, 0.f, 0.f};
#pragma unroll
            for (int kk = 0; kk < 4; ++kk) { const bf16x8 kf = *(const LAS bf16x8*)(Ks + (16 * kt + fr) * PC + (32 * kk + 8 * fq) * 2);
                z[kt] = __builtin_amdgcn_mfma_f32_16x16x32_bf16(kf, qf[kk], z[kt], 0, 0, 0); } }
        f32x4 lk[4]; float T[4];
#pragma unroll
        for (int kt = 0; kt < 4; ++kt) {
#pragma unroll
            for (int e = 0; e < 4; ++e) { const float zz = z[kt][e]; const bool ok = (s0 + 16 * kt + 4 * fq + e) < tq;
                const float v = -(fmaxf(zz, 0.f) + __logf(1.0f + __expf(-fabsf(zz)))); lk[kt][e] = ok ? v : 0.f; }
            T[kt] = (lk[kt][0] + lk[kt][1]) + (lk[kt][2] + lk[kt][3]); }
        float run = R;
        f32x4 P[4];
#pragma unroll
        for (int kt = 3; kt >= 0; --kt) {
            const float t1 = __shfl_xor(T[kt], 16), t2 = __shfl_xor(T[kt], 32), t3 = __shfl_xor(T[kt], 48);
            const float g = (((fq ^ 1) > fq) ? t1 : 0.f) + (((fq ^ 2) > fq) ? t2 : 0.f) + (((fq ^ 3) > fq) ? t3 : 0.f);
            float suf = run + g;
#pragma unroll
            for (int e = 3; e >= 0; --e) { const bool ok = (s0 + 16 * kt + 4 * fq + e) < tq;
                P[kt][e] = ok ? __expf(lk[kt][e] + z[kt][e] + suf) : 0.f; suf += lk[kt][e]; }
            run += (T[kt] + t1) + (t2 + t3);
        }
        R = run;
#pragma unroll
        for (int kp = 0; kp < 2; ++kp) {
            const bf16x8 pf = frag2(pack4(P[2 * kp]), pack4(P[2 * kp + 1]));
#pragma unroll
            for (int dt = 0; dt < 8; ++dt) {
                const int vr = 32 * (dt >> 1) + 8 * (fr >> 2) + 4 * (dt & 1) + (fr & 3);
                const bf16x8 vf = frag2(*(const LAS u32x2*)(VTs + vr * PT + (32 * kp + 4 * fq) * 2), *(const LAS u32x2*)(VTs + vr * PT + (32 * kp + 16 + 4 * fq) * 2));
                O[dt] = __builtin_amdgcn_mfma_f32_16x16x32_bf16(vf, pf, O[dt], 0, 0, 0);
            }
        }
        { const bool done = R < -60.f; const unsigned long long bal = __ballot(done); wdone = (bal == ~0ull); if (lane == 0) FL[wave] = wdone ? 1u : 0u; }
        }
        __syncthreads();
    }
    bf16_t* op = dummy ? (bf16_t*)(ws + WS_VB) + (row0 + tq) * 512 + h * 128 + 8 * fq : QAB + (row0 + tq) * 1024 + 512 + h * 128 + 8 * fq;
#pragma unroll
    for (int k = 0; k < 4; ++k) { const u32x2 lo = pack4(O[2 * k]), hi = pack4(O[2 * k + 1]); *(u32x4*)(op + 32 * k) = (u32x4){lo.x, lo.y, hi.x, hi.y}; }
    __syncthreads();
}

__device__ __forceinline__ void gmix_phase(const Params& p, int o, LAS unsigned char* lds, int vcu, int G, int tid, int wave, int lane) {
    unsigned char* ws = p.ws;
    const bf16_t* VT = (const bf16_t*)(ws + WS_VT); bf16_t* U = (bf16_t*)(ws + WS_U);
    const float* S1 = (const float*)(ws + WS_LNP + (size_t)(2 * o) * LNP_STRIDE); const float* S2 = (const float*)(ws + WS_LNP + (size_t)(2 * o + 1) * LNP_STRIDE);
    const float* lng = p.in[I_LNG] + o * 3072; const float* lnb = p.in[I_LNB] + o * 3072;
    constexpr int PITCH = 272;
    LAS unsigned char* Wp = lds; LAS unsigned char* VTs = lds + 128 * PITCH;
    LAS float* AL = (LAS float*)(lds + 128 * PITCH + 192 * PITCH); LAS float* BE = AL + 128;
    LAS float* MUA = BE + 128; LAS float* RSA = MUA + 512;
    LAS float* LG = RSA + 512; LAS float* LBt = LG + 384;
    const int fr = lane & 15, fq = lane >> 4;
    const int wt = tid >> 2, wsq = tid & 3;
    f32x4 wreg[8];
    u32x4 vreg[6]; u32x4 ureg[6];
#define GM_LOADV(n_, g_, half_) do { _Pragma("unroll") for (int i = 0; i < 6; ++i) { const int idx = tid + NTHREADS * i; \
        vreg[i] = *(const u32x4*)(VT + ((size_t)(n_) * 3072 + (g_) * 384 + (half_) * 192 + (idx >> 4)) * 128 + (idx & 15) * 8); } } while (0)
#define GM_STOREV() do { _Pragma("unroll") for (int i = 0; i < 6; ++i) { const int idx = tid + NTHREADS * i; *(LAS u32x4*)(VTs + (idx >> 4) * PITCH + (idx & 15) * 16) = vreg[i]; } } while (0)
#define GM_LOADU(dst_, n_, g_, half_) do { _Pragma("unroll") for (int kp = 0; kp < 6; ++kp) dst_[kp] = *(const u32x4*)(U + (size_t)((n_) * 128 + 16 * wave + fr) * 3072 + (g_) * 384 + (half_) * 192 + 32 * kp + 8 * fq); } while (0)
    if (vcu < 1024) GM_LOADV(vcu >> 3, vcu & 7, 0);
    __syncthreads();
    {
        const int k = tid >> 7, tk = tid & 127, unit = vcu + k * G;
        if (unit < 1024 && k < 4) { const size_t tok = (size_t)(unit >> 3) * 128 + tk; float a1 = 0.f, a2 = 0.f;
#pragma unroll
            for (int j = 0; j < 6; ++j) { const f32x4 x = *(const f32x4*)(S1 + tok * 24 + 4 * j), y = *(const f32x4*)(S2 + tok * 24 + 4 * j); a1 += (x[0] + x[1]) + (x[2] + x[3]); a2 += (y[0] + y[1]) + (y[2] + y[3]); }
            const float mu = a1 * (1.0f / 3072.0f); const float var = a2 * (1.0f / 3072.0f) - mu * mu; MUA[tid] = mu; RSA[tid] = __builtin_amdgcn_rsqf(fmaxf(var, 0.f) + 1e-6f); }
    }
    int kslot = 0;
    for (int unit = vcu; unit < 1024; unit += G, ++kslot) {
        const int n = unit >> 3, g = unit & 7, T0 = n * 128;
        __syncthreads();
        GM_STOREV();
        GM_LOADU(ureg, n, g, 0);
        { const float* wrow = p.in[I_GMWS] + ((size_t)(o * 8 + g) * 128 + wt) * 128 + 32 * wsq;
#pragma unroll
          for (int j = 0; j < 8; ++j) wreg[j] = *(const f32x4*)(wrow + 4 * j); }
        const LAS float* MU = MUA + 128 * kslot; const LAS float* RS = RSA + 128 * kslot;
        {
            float al = 0.f, be = 0.f;
#pragma unroll
            for (int j = 0; j < 4; ++j) {
                unsigned pk[4];
#pragma unroll
                for (int e2 = 0; e2 < 4; ++e2) {
                    unsigned bits[2];
#pragma unroll
                    for (int hh = 0; hh < 2; ++hh) {
                        const int e = 2 * e2 + hh, s = 32 * wsq + 8 * j + e;
                        float w = wreg[2 * j + (e >> 2)][e & 3]; w = (s <= wt) ? w : 0.f; be += w;
                        bits[hh] = f2bf(w * RS[s]); al += __uint_as_float(bits[hh] << 16) * MU[s];
                    }
                    pk[e2] = bits[0] | (bits[1] << 16);
                }
                *(LAS u32x4*)(Wp + wt * PITCH + (32 * wsq + 8 * j) * 2) = (u32x4){pk[0], pk[1], pk[2], pk[3]};
            }
            al += __shfl_xor(al, 1); al += __shfl_xor(al, 2); be += __shfl_xor(be, 1); be += __shfl_xor(be, 2);
            if (wsq == 0) { AL[wt] = al; BE[wt] = be; }
        }
        GM_LOADV(n, g, 1);
        __syncthreads();
        const int t = 16 * wave + fr; const float al = AL[t], be = BE[t], bsv = p.in[I_GMBS][(o * 8 + g) * 128 + t];
        const int nks = ((16 * wave + 15) >> 5) + 1;
        const float* lngu = lng; const float* lnbu = lnb; asm volatile("" : "+s"(lngu), "+s"(lnbu));
#pragma unroll
        for (int half = 0; half < 2; ++half) {
            const int cg0 = g * 384 + half * 192;
            if (half) { __syncthreads();
                GM_STOREV(); GM_LOADU(ureg, n, g, 1);
                if (unit + G < 1024) GM_LOADV((unit + G) >> 3, (unit + G) & 7, 0);
                __syncthreads(); }
            f32x4 acc[12];
#pragma unroll
            for (int ct = 0; ct < 12; ++ct) acc[ct] = (f32x4){0.f, 0.f, 0.f, 0.f};
            for (int ks = 0; ks < nks; ++ks) {
                const bf16x8 bfrag = *(const LAS bf16x8*)(Wp + (16 * wave + fr) * PITCH + (32 * ks + 8 * fq) * 2);
#pragma unroll
                for (int ct = 0; ct < 12; ++ct) { const bf16x8 afrag = *(const LAS bf16x8*)(VTs + (32 * (ct >> 1) + 8 * (fr >> 2) + 4 * (ct & 1) + (fr & 3)) * PITCH + (32 * ks + 8 * fq) * 2);
                    acc[ct] = __builtin_amdgcn_mfma_f32_16x16x32_bf16(afrag, bfrag, acc[ct], 0, 0, 0); }
            }
#pragma unroll
            for (int kp = 0; kp < 6; ++kp) {
                const int cl = half * 192 + 32 * kp + 8 * fq, cg = g * 384 + cl;
                const f32x4 lg0 = *(const f32x4*)(lngu + cg), lg1 = *(const f32x4*)(lngu + cg + 4), lb0 = *(const f32x4*)(lnbu + cg), lb1 = *(const f32x4*)(lnbu + cg + 4);
                const u32x4 uu = ureg[kp]; const f32x4 a0 = acc[2 * kp], a1 = acc[2 * kp + 1];
                u32x4 w;
                w.x = pg8::cvt_pk_bf16(bflo(uu.x) * (lg0[0] * (a0[0] - al) + lb0[0] * be + bsv), bfhi(uu.x) * (lg0[1] * (a0[1] - al) + lb0[1] * be + bsv));
                w.y = pg8::cvt_pk_bf16(bflo(uu.y) * (lg0[2] * (a0[2] - al) + lb0[2] * be + bsv), bfhi(uu.y) * (lg0[3] * (a0[3] - al) + lb0[3] * be + bsv));
                w.z = pg8::cvt_pk_bf16(bflo(uu.z) * (lg1[0] * (a1[0] - al) + lb1[0] * be + bsv), bfhi(uu.z) * (lg1[1] * (a1[1] - al) + lb1[1] * be + bsv));
                w.w = pg8::cvt_pk_bf16(bflo(uu.w) * (lg1[2] * (a1[2] - al) + lb1[2] * be + bsv), bfhi(uu.w) * (lg1[3] * (a1[3] - al) + lb1[3] * be + bsv));
                *(u32x4*)(U + (size_t)(T0 + t) * 3072 + cg) = w;
            }
            (void)cg0;
        }
    }
#undef GM_LOADV
#undef GM_STOREV
#undef GM_LOADU
}

constexpr size_t OFF_BAR = 512 * 1024;
#define XB_TMO      128
#define XB_XCNT(j)  (256  + 64 * (j))
#define XB_XSUB(j)  (1280 + 64 * (j))
#define XB_XGEN(j)  (2304 + 64 * (j))
#define XB_TOP      3328
#define XB_TOPGEN   3392
#define XCD_BAR_WORDS 3456
#define XB_SPIN_CAP (1u << 18)

__device__ __forceinline__ unsigned xb_ld(unsigned* p)              { return __hip_atomic_load(p, __ATOMIC_RELAXED, __HIP_MEMORY_SCOPE_AGENT); }
__device__ __forceinline__ unsigned xb_add(unsigned* p, unsigned v) { return __hip_atomic_fetch_add(p, v, __ATOMIC_RELAXED, __HIP_MEMORY_SCOPE_AGENT); }
__device__ __forceinline__ unsigned xb_xcc_id() { return (unsigned)__builtin_amdgcn_s_getreg((3 << 11) | 20) & 0xFu; }
#define XB_SPIN(cond, bar) do { unsigned _sp = 0; while (cond) { __builtin_amdgcn_s_sleep(1); \
    if ((++_sp & 255u) == 0u) { if (xb_ld(&(bar)[XB_TMO])) break; if (_sp > XB_SPIN_CAP) { atomicAdd(&(bar)[XB_TMO], 1u); break; } } } } while (0)

struct XcdBarrier {
    unsigned* bar; unsigned x;
    volatile LAS unsigned* st;
};

__device__ __forceinline__ XcdBarrier xcd_barrier_post(unsigned* bar, volatile LAS unsigned* st) {
    XcdBarrier b; b.bar = bar; b.x = xb_xcc_id(); b.st = st;
    if (threadIdx.x == 0) (void)xb_add(&bar[XB_XCNT(b.x)], 1u);
    return b;
}
__device__ __forceinline__ void xcd_barrier_complete(unsigned* bar, unsigned x, unsigned& nloc, unsigned& nx) {
    const unsigned G = gridDim.x * gridDim.y * gridDim.z;
    unsigned sum, cnt, mine, sp = 0u;
    for (;;) {
        sum = 0u; cnt = 0u; mine = 0u;
#pragma unroll
        for (unsigned j = 0; j < 16; ++j) { const unsigned c = xb_ld(&bar[XB_XCNT(j)]); sum += c; cnt += (c > 0u) ? 1u : 0u; mine = (j == x) ? c : mine; }
        if (sum == G) break;
        __builtin_amdgcn_s_sleep(1);
        if ((++sp & 255u) == 0u) { if (xb_ld(&bar[XB_TMO])) break; if (sp > XB_SPIN_CAP) { atomicAdd(&bar[XB_TMO], 1u); break; } }
    }
    nloc = mine > 0u ? mine : 1u; nx = cnt > 0u ? cnt : 1u;
}

__device__ __forceinline__ void xcd_barrier(const XcdBarrier& b) {
    asm volatile("s_waitcnt vmcnt(0)" ::: "memory");
    __syncthreads();
    if (threadIdx.x == 0) {
        unsigned* bar = b.bar;
        __builtin_amdgcn_s_waitcnt(0);
        unsigned nloc = b.st[0], nx = b.st[1];
        if (nloc == 0u) { xcd_barrier_complete(bar, b.x, nloc, nx); b.st[0] = nloc; b.st[1] = nx; }
        const unsigned old = xb_add(&bar[XB_XSUB(b.x)], 1u);
        const unsigned gen = old / nloc;
        if (old + 1u == (gen + 1u) * nloc) {
            __builtin_amdgcn_fence(__ATOMIC_RELEASE, "agent");
            asm volatile("s_waitcnt vmcnt(0)" ::: "memory");
            const unsigned og = xb_add(&bar[XB_TOP], 1u);
            const unsigned tg = og / nx;
            if (og + 1u == (tg + 1u) * nx) xb_add(&bar[XB_TOPGEN], 1u);
            else XB_SPIN(xb_ld(&bar[XB_TOPGEN]) == tg, bar);
            __builtin_amdgcn_fence(__ATOMIC_ACQUIRE, "agent");
            xb_add(&bar[XB_XGEN(b.x)], 1u);
            asm volatile("s_waitcnt vmcnt(0)" ::: "memory");
        } else {
            XB_SPIN(xb_ld(&bar[XB_XGEN(b.x)]) == gen, bar);
            __builtin_amdgcn_fence(__ATOMIC_ACQUIRE, "agent");
            asm volatile("s_waitcnt vmcnt(0)" ::: "memory");
        }
    }
    __syncthreads();
}

template <class Sched> __device__ __forceinline__ void rstd_table(const Sched& S, const float* ssq, bool cols, LAS float* tab, int tid) {
    pg8::Unit u;
    for (int i = 0; S.next(i, u); ++i) {
        const int base = (cols ? u.pn : u.pm) * 256;
#pragma unroll
        for (int k = 0; k < 2; ++k) { const int idx = tid + NTHREADS * k, r = idx >> 2, qd = idx & 3;
            const f32x4 v = *(const f32x4*)(ssq + (size_t)(base + r) * 16 + 4 * qd); float t = (v[0] + v[1]) + (v[2] + v[3]);
            t += __shfl_xor(t, 1); t += __shfl_xor(t, 2);
            if (qd == 0) tab[i * 256 + r] = __builtin_amdgcn_rsqf(t * (1.0f / 1024.0f) + 1e-6f); }
    }
    __syncthreads();
}
#ifndef PROBE
#define PROBE 0
#endif
#define REP(mask) for (int rep_ = ((PROBE) & (mask)) ? 0 : 1; rep_ < 2; ++rep_)
__global__ void __launch_bounds__(NTHREADS, 2) fwd(Params p) {
    extern __shared__ __attribute__((aligned(16))) unsigned char lds_raw[];
    LAS unsigned char* lds = (LAS unsigned char*)lds_raw;
    cg::grid_group grid = cg::this_grid();
    int tid = threadIdx.x, lane = tid & 63;
    const int wave = __builtin_amdgcn_readfirstlane(tid >> 6);
    const int G = gridDim.x, bx = blockIdx.x;
    const int vcu = (G % 8 == 0) ? (bx % 8) * (G / 8) + bx / 8 : bx;
    const int gw = vcu * NWAVES + wave, ngw = G * NWAVES;
    Params q = p;
    LAS float* RST = (LAS float*)(lds + 131072);
    volatile LAS unsigned* bst = (volatile LAS unsigned*)(lds + LDS_BYTES - 64);
    if (tid < 2) bst[tid] = 0u;
    __syncthreads();
    XcdBarrier xbar = xcd_barrier_post((unsigned*)(p.ws + OFF_BAR), bst);
    int ph = 0;
#define PHASE_BEGIN() (ph >= p.ph_lo && ph < p.ph_hi)
#define PHASE_END() do { if (ph >= p.ph_lo && ph + 1 < p.ph_hi) { REP(32) { xcd_barrier(xbar); } } ++ph; } while (0)
#define LAUNDER() asm volatile("" : "+s"(q.out), "+s"(q.ws), "+v"(tid), "+v"(lane)); \
    unsigned char* ws = q.ws; float* SSQ = (float*)(ws + WS_SSQ); bf16_t* XB = (bf16_t*)(ws + WS_XB); (void)SSQ; (void)XB

    if (PHASE_BEGIN()) {
        LAUNDER();
        if (bx == 0) { float* LB = (float*)(ws + OFF_LB); const float* lg = q.in[I_LBL];
            const float l0 = lg[tid], l1 = lg[512 + tid], mx = fmaxf(l0, l1), e0 = __expf(l0 - mx), e1 = __expf(l1 - mx), inv = 1.0f / (e0 + e1);
            const float c0 = e0 * inv, c1 = c0 + e1 * inv; LB[tid] = c0 - c0; LB[512 + tid] = c1 - c0; }
        for (int row = gw; row < M; row += ngw) {
            const f32x4* xr = (const f32x4*)(q.in[I_X] + (size_t)row * D) + lane; f32x4 v[4]; float s = 0.f;
#pragma unroll
            for (int j = 0; j < 4; ++j) { v[j] = xr[64 * j]; s += (v[j][0] * v[j][0] + v[j][1] * v[j][1]) + (v[j][2] * v[j][2] + v[j][3] * v[j][3]); }
            s = wave_sum(s); if (lane < 4) *(f32x4*)(SSQ + (size_t)row * 16 + 4 * lane) = (f32x4){lane == 0 ? s : 0.f, 0.f, 0.f, 0.f};
            u32x2* o8 = (u32x2*)(XB + (size_t)row * D) + lane;
#pragma unroll
            for (int j = 0; j < 4; ++j) { u32x2 w; w.x = pk2(v[j][0], v[j][1]); w.y = pk2(v[j][2], v[j][3]); o8[64 * j] = w; }
        }
        conv_chore(q, 0, 1 | 2 | 4, lds, gw, ngw, wave, lane);
    }
    if (p.ph_lo < 0) grid.sync();
    PHASE_END();

    for (int layer = 0; layer < 4; ++layer) {
        const int e = layer >> 1;
        const bool grpA = ((bx >> 3) & 1) == 0;
        if ((layer & 1) == 0) {
            if (PHASE_BEGIN()) REP(2) {
                { LAUNDER(); const float* ssq_mix = SSQ + (size_t)(2 * layer) * M * 16;
                  pg8::Gemm g{XB, (const bf16_t*)(ws + WS_WA), M, 2560, 1024}; pg8::StaticOrder S; S.init(M, 2560, G, bx);
                  rstd_table(S, ssq_mix, false, RST, tid); pg8::EpiProj E{RST, (const float*)(ws + OFF_LB) + e * 512, q.in[I_HON] + e * 512, (bf16_t*)(ws + WS_QAB), (bf16_t*)(ws + WS_KA), (float*)(ws + WS_LF), (bf16_t*)(ws + WS_GA), (bf16_t*)(ws + WS_KB), 0};
                  pg8::gemm_phase<pg8::EpiProj, pg8::StaticOrder, true, true>(lds, g, S, E); }
                { LAUNDER(); const float* ssq_mix = SSQ + (size_t)(2 * layer) * M * 16;
                  pg8::Gemm g{(const bf16_t*)(ws + WS_WB), XB, 1024, M, 1024}; pg8::StaticOrder S; S.init(1024, M, G, bx);
                  rstd_table(S, ssq_mix, true, RST, tid); pg8::EpiT<0> E{RST, (bf16_t*)(ws + WS_IAT), 1024, nullptr, nullptr};
                  pg8::gemm_phase<pg8::EpiT<0>, pg8::StaticOrder, true, true>(lds, g, S, E); }
            }
            PHASE_END();
            if (PHASE_BEGIN()) { REP(4) { LAUNDER(); for (int u = vcu; u < 256; u += G) hgrn_unit<false>(q, u, lds, tid, wave, lane); } REP(8) { LAUNDER(); for (int u = vcu; u < 512; u += G) attn_unit(q, (u & ~31) | (31 - (u & 31)), lds, tid, wave, lane, rep_ == 0); } }
            PHASE_END();
            if (PHASE_BEGIN()) { LAUNDER(); hgrn_scan(q, vcu * NTHREADS + tid, G * NTHREADS); }
            PHASE_END();
            if (PHASE_BEGIN()) REP(16) { LAUNDER(); for (int u = vcu; u < 256; u += G) hgrn_unit<true>(q, u, lds, tid, wave, lane, rep_ == 0); }
            PHASE_END();
        } else {
            if (PHASE_BEGIN()) REP(2) {
                { LAUNDER(); const float* ssq_mix = SSQ + (size_t)(2 * layer) * M * 16;
                  pg8::Gemm g{XB, (const bf16_t*)(ws + WS_WA), M, 3072, 1024}; pg8::StaticOrder S; S.init(M, 3072, G, bx);
                  rstd_table(S, ssq_mix, false, RST, tid); pg8::EpiRow<1> E{RST, (bf16_t*)(ws + WS_U), 3072};
                  pg8::gemm_phase<pg8::EpiRow<1>, pg8::StaticOrder, true, true>(lds, g, S, E); }
                { LAUNDER(); const float* ssq_mix = SSQ + (size_t)(2 * layer) * M * 16;
                  pg8::Gemm g{(const bf16_t*)(ws + WS_WB), XB, 3072, M, 1024}; pg8::StaticOrder S; S.init(3072, M, G, bx);
                  rstd_table(S, ssq_mix, true, RST, tid); pg8::EpiT<1> E{RST, (bf16_t*)(ws + WS_VT), 3072, (float*)(ws + WS_LNP + (size_t)(2 * e) * LNP_STRIDE), (float*)(ws + WS_LNP + (size_t)(2 * e + 1) * LNP_STRIDE)};
                  pg8::gemm_phase<pg8::EpiT<1>, pg8::StaticOrder, true, true>(lds, g, S, E); }
            }
            PHASE_END();
            if (PHASE_BEGIN()) { LAUNDER(); gmix_phase(q, e, lds, vcu, G, tid, wave, lane); }
            PHASE_END();
        }
        for (int r = 0; r < 2; ++r) {
            if (r == 1) {
                if (PHASE_BEGIN()) { LAUNDER();
                    if (grpA) { conv_chore(q, layer + 1, 2, lds, gw, ngw, wave, lane); __syncthreads(); }
                    { pg8::Gemm g{XB, (const bf16_t*)(ws + WS_W1), M, 4096, 1024}; pg8::StaticOrder S; S.init(M, 4096, G, bx);
                    rstd_table(S, SSQ + (size_t)(2 * layer + 1) * M * 16, false, RST, tid); pg8::EpiRow<2> E{RST, (bf16_t*)(ws + WS_H), 4096};
                    pg8::gemm_phase<pg8::EpiRow<2>, pg8::StaticOrder, true, true>(lds, g, S, E); }
                    if (!grpA) { __syncthreads(); conv_chore(q, layer + 1, 2, lds, gw, ngw, wave, lane); } }
                PHASE_END();
            }
            if (PHASE_BEGIN()) {
                LAUNDER(); const int rep_ = 1;
                if (grpA) { if (r == 0) { conv_chore(q, layer, 8, lds, gw, ngw, wave, lane); conv_chore(q, layer + 1, 1, lds, gw, ngw, wave, lane); } else conv_chore(q, layer + 1, 4, lds, gw, ngw, wave, lane); __syncthreads(); }
                const bf16_t* A = r ? (const bf16_t*)(ws + WS_H) : (const bf16_t*)(ws + WS_ACT);
                const int K = r ? 4096 : ((layer & 1) ? 3072 : 1024);
                pg8::Gemm g{A, (const bf16_t*)(ws + (r ? WS_W2 : WS_WO)), M, 1024, K}; pg8::StaticOrder S; S.init(M, 1024, G, bx);
                pg8::EpiRes E{XB, SSQ + (size_t)(2 * layer + 1 + r) * M * 16};
                pg8::gemm_phase<pg8::EpiRes, pg8::StaticOrder, true, true>(lds, g, S, E);
                if (!grpA) { __syncthreads(); if (r == 0) { conv_chore(q, layer, 8, lds, gw, ngw, wave, lane); conv_chore(q, layer + 1, 1, lds, gw, ngw, wave, lane); } else conv_chore(q, layer + 1, 4, lds, gw, ngw, wave, lane); }
            }
            PHASE_END();
        }
    }
    if (PHASE_BEGIN()) {
        LAUNDER();
        const float* fn = q.in[I_FN]; const float* sq = SSQ + (size_t)8 * M * 16;
        for (int row = gw; row < M; row += ngw) {
            const float r = pg8::rstd1024(sq + (size_t)row * 16);
            f32x4* xr = (f32x4*)(q.out + (size_t)row * D) + lane; const u32x2* xb = (const u32x2*)(XB + (size_t)row * D) + lane;
#pragma unroll
            for (int j = 0; j < 4; ++j) { const f32x4 gn = *((const f32x4*)fn + lane + 64 * j); const u32x2 w = xb[64 * j];
                xr[64 * j] = (f32x4){bflo(w.x), bfhi(w.x), bflo(w.y), bfhi(w.y)} * r * gn; }
        }
    }
}
constexpr int N_PHASES = 1 + 3 + 2 * (4 + 3) + 2 * (3 + 3) + 1;

extern "C" void kernel_launch(void* const* d_in, const int* in_sizes, int n_in, void* d_out, int out_size, void* d_ws, size_t ws_size, hipStream_t stream) {
    static int grid = 0;
    if (grid == 0) {
        if (n_in != 16 || out_size != M * D || ws_size < WS_END) { fprintf(stderr, "kernel_launch: unexpected shapes: n_in %d out %d ws %zu (need %zu)\n", n_in, out_size, ws_size, (size_t)WS_END); grid = -1; return; }
        int dev = 0, cus = 0, per_cu = 0;
        hipGetDevice(&dev); hipDeviceGetAttribute(&cus, hipDeviceAttributeMultiprocessorCount, dev);
        hipFuncSetAttribute((const void*)fwd, hipFuncAttributeMaxDynamicSharedMemorySize, LDS_BYTES);
        hipOccupancyMaxActiveBlocksPerMultiprocessor(&per_cu, (const void*)fwd, NTHREADS, LDS_BYTES);
        (void)hipGetLastError();
        if (per_cu < 1) per_cu = 1;
        grid = cus * per_cu;
        if (grid < 256 || (grid & 7)) { fprintf(stderr, "kernel_launch: grid %d unsupported (needs a multiple of 8, >= 256)\n", grid); grid = -1; return; }
        fprintf(stderr, "kernel_launch: grid %d (cus %d x %d)\n", grid, cus, per_cu);
    }
    if (grid < 0) return;
    Params p{};
    for (int i = 0; i < 16; ++i) p.in[i] = (const float*)d_in[i];
    p.out = (float*)d_out; p.ws = (unsigned char*)d_ws; p.ph_lo = 0; p.ph_hi = 1 << 20;
    if (hipMemsetAsync((char*)d_ws + OFF_BAR, 0, 16384, stream) != hipSuccess) fprintf(stderr, "kernel_launch: memset of barrier words failed\n");
    void* args[] = {&p};
    hipError_t err = hipLaunchCooperativeKernel((const void*)fwd, dim3(grid), dim3(NTHREADS), args, LDS_BYTES, stream);
    if (err != hipSuccess) fprintf(stderr, "kernel_launch: cooperative launch failed: %s (grid %d)\n", hipGetErrorString(err), grid);
}
```
